# Optimizing an MI355X kernel written in HIP

```python
import math
import jax, jax.numpy as jnp
from jax import lax
import numpy as np


D_MODEL = 1024
BATCH = 4
SEQ = 4096
DEPTH = 2
DEC_BATCH = 32
DEC_SEQ = 16
PAST_LEN = 1024

CHUNK = 64
EPS = 1e-5
D_MIX = D_MODEL
GROUP_WIDTH = D_MIX // 4

SSM_INNER = GROUP_WIDTH
SSM_HEAD_DIM = 64
SSM_HEADS = SSM_INNER // SSM_HEAD_DIM
SSM_STATE = 128
SSM_CONV = 4
SSM_CONV_DIM = SSM_INNER + 2 * SSM_STATE

SWA_HEAD_DIM = 64
SWA_HEADS = GROUP_WIDTH // SWA_HEAD_DIM
SWA_KV_HEADS = 2
SWA_GROUP = SWA_HEADS // SWA_KV_HEADS
WINDOW = 128
WIN_CHUNKS = WINDOW // CHUNK

SC_WIDTH = GROUP_WIDTH
SC_CONV = 3

CC_WIDTH = GROUP_WIDTH
CC_CONV = 31

D_FF = ((8 * D_MODEL + 3 * 256 - 1) // (3 * 256)) * 256

IN_SIZES = (SSM_INNER, SSM_CONV_DIM, SSM_HEADS,
            SWA_HEADS * SWA_HEAD_DIM, SWA_KV_HEADS * SWA_HEAD_DIM, SWA_KV_HEADS * SWA_HEAD_DIM,
            3 * SC_WIDTH, 2 * CC_WIDTH)
IN_SPLITS = tuple(int(v) for v in np.cumsum(IN_SIZES)[:-1])
D_IN = int(sum(IN_SIZES))

kernel_name = 'hybrid_ssd_swa_conv_stream_step'


def rms_norm(x, g):
    xf = x.astype(jnp.float32)
    y = xf * lax.rsqrt(jnp.mean(xf * xf, axis=-1, keepdims=True) + EPS)
    return (y * g.astype(jnp.float32)).astype(x.dtype)


def layer_norm(x, g, b):
    xf = x.astype(jnp.float32)
    xc = xf - jnp.mean(xf, axis=-1, keepdims=True)
    var = jnp.mean(xc * xc, axis=-1, keepdims=True)
    return (xc * lax.rsqrt(var + EPS) * g.astype(jnp.float32) + b.astype(jnp.float32)).astype(x.dtype)


def causal_dwconv(u, buf, w, b=None):
    width, ch = w.shape
    full = jnp.concatenate([buf.astype(u.dtype), u], axis=1)
    y = lax.conv_general_dilated(full, w.astype(u.dtype)[:, None, :], window_strides=(1,), padding='VALID',
                                 dimension_numbers=('NWC', 'WIO', 'NWC'), feature_group_count=ch)
    if b is not None:
        y = y + b.astype(u.dtype)
    return y, full[:, full.shape[1] - (width - 1):]


def ssd_scan(x, dt, A, Bm, Cm, h0, block):
    f32 = jnp.float32
    n, L, H, P = x.shape
    N = Bm.shape[-1]
    nc = L // block
    xc = x.reshape(n, nc, block, H, P).astype(f32)
    dtc = dt.reshape(n, nc, block, H).astype(f32)
    Bc = Bm.reshape(n, nc, block, N).astype(f32)
    Cc = Cm.reshape(n, nc, block, N).astype(f32)
    acum = jnp.cumsum(dtc * A.astype(f32), axis=2)
    seg = acum[:, :, :, None, :] - acum[:, :, None, :, :]
    causal = jnp.tril(jnp.ones((block, block), dtype=bool))[None, None, :, :, None]
    decay = jnp.exp(jnp.where(causal, seg, -jnp.inf))
    xdt = xc * dtc[..., None]
    cb = jnp.einsum('bcis,bcjs->bcij', Cc, Bc)
    y_intra = jnp.einsum('bcij,bcijh,bcjhp->bcihp', cb, decay, xdt)
    to_end = jnp.exp(acum[:, :, -1:, :] - acum)
    blk_states = jnp.einsum('bcjs,bcjh,bcjhp->bchps', Bc, to_end, xdt)
    blk_decay = jnp.exp(acum[:, :, -1, :])

    def step(h, inp):
        d, s = inp
        return d[:, :, None, None] * h + s, h

    h_last, h_starts = lax.scan(step, h0.astype(f32),
                                (jnp.moveaxis(blk_decay, 1, 0), jnp.moveaxis(blk_states, 1, 0)))
    h_starts = jnp.moveaxis(h_starts, 0, 1)
    y_inter = jnp.einsum('bcis,bchps,bcih->bcihp', Cc, h_starts, jnp.exp(acum))
    return (y_intra + y_inter).reshape(n, L, H, P), h_last


def mixer_ssd(z, xbc, dt_raw, conv_buf, h0, conv_w, conv_b, dt_bias, a_log, d_skip, norm_g, block):
    f32 = jnp.float32
    n, L, _ = z.shape
    xbc, new_buf = causal_dwconv(xbc, conv_buf, conv_w, conv_b)
    xbc = jax.nn.silu(xbc)
    xs, Bm, Cm = jnp.split(xbc, [SSM_INNER, SSM_INNER + SSM_STATE], axis=-1)
    dt = jax.nn.softplus(dt_raw.astype(f32) + dt_bias.astype(f32))
    A = -jnp.exp(a_log.astype(f32))
    xh = xs.reshape(n, L, SSM_HEADS, SSM_HEAD_DIM)
    y, h_last = ssd_scan(xh, dt, A, Bm, Cm, h0, block)
    y = y + d_skip.astype(f32)[:, None] * xh.astype(f32)
    y = y.reshape(n, L, SSM_INNER) * jax.nn.silu(z.astype(f32))
    y = rms_norm(y, norm_g)
    return y.astype(z.dtype), new_buf, h_last.astype(h0.dtype)


def alibi_slopes(n):
    return 2.0 ** (-8.0 * jnp.arange(1, n + 1, dtype=jnp.float32) / n)


def banded_attention(q, k, v, qpos, kpos, sinks):
    f32 = jnp.float32
    s = jnp.einsum('ncikgd,ncjkd->nckgij', q.astype(f32), k.astype(f32)) * (SWA_HEAD_DIM ** -0.5)
    slopes = alibi_slopes(SWA_HEADS).reshape(SWA_KV_HEADS, SWA_GROUP)
    dist = jnp.abs(qpos[:, :, None] - kpos[:, None, :]).astype(f32)
    s = s - slopes[None, None, :, :, None, None] * dist[None, :, None, None]
    qc, kc = qpos // CHUNK, kpos // CHUNK
    valid = ((kpos[:, None, :] >= 0) & (kc[:, None, :] <= qc[:, :, None])
             & (kc[:, None, :] >= qc[:, :, None] - WIN_CHUNKS))
    s = jnp.where(valid[None, :, None, None], s, -jnp.inf)
    sink = jnp.broadcast_to(sinks.astype(f32).reshape(SWA_KV_HEADS, SWA_GROUP)[None, None, :, :, None, None],
                            s.shape[:-1] + (1,))
    p = jax.nn.softmax(jnp.concatenate([s, sink], axis=-1), axis=-1)[..., :-1]
    return jnp.einsum('nckgij,ncjkd->ncikgd', p, v.astype(f32))


def swa_prompt(q, k, v, sinks):
    n, L = q.shape[:2]
    nc = L // CHUNK
    pad = WIN_CHUNKS * CHUNK

    def band(t):
        tp = jnp.pad(t, ((0, 0), (pad, 0), (0, 0), (0, 0)))
        tc = tp.reshape(n, nc + WIN_CHUNKS, CHUNK, SWA_KV_HEADS, SWA_HEAD_DIM)
        return jnp.concatenate([tc[:, w:w + nc] for w in range(WIN_CHUNKS + 1)], axis=2)

    qb = q.reshape(n, nc, CHUNK, SWA_KV_HEADS, SWA_GROUP, SWA_HEAD_DIM)
    qpos = jnp.arange(L).reshape(nc, CHUNK)
    kpos = jnp.arange(nc)[:, None] * CHUNK - pad + jnp.arange((WIN_CHUNKS + 1) * CHUNK)[None, :]
    o = banded_attention(qb, band(k), band(v), qpos, kpos, sinks)
    return o.reshape(n, L, SWA_HEADS * SWA_HEAD_DIM)


def swa_sample(q, k, v, k_cache, v_cache, sinks):
    n, L = q.shape[:2]
    wc = k_cache.shape[1]
    k_all = jnp.concatenate([k_cache.astype(k.dtype), k], axis=1)[:, None]
    v_all = jnp.concatenate([v_cache.astype(v.dtype), v], axis=1)[:, None]
    qpos = (PAST_LEN + jnp.arange(L))[None]
    kpos = jnp.concatenate([PAST_LEN - wc + jnp.arange(wc), PAST_LEN + jnp.arange(L)])[None]
    o = banded_attention(q[:, None], k_all, v_all, qpos, kpos, sinks)
    return o.reshape(n, L, SWA_HEADS * SWA_HEAD_DIM)


def mixer_shortconv(u, buf, w):
    bg, cg, h = jnp.split(u, 3, axis=-1)
    y, new_buf = causal_dwconv(cg * h, buf, w)
    return bg * y, new_buf


def mixer_conformer(u, buf, w, b, ln_g, ln_b):
    a, g = jnp.split(u, 2, axis=-1)
    glu = a * jax.nn.sigmoid(g)
    y, new_buf = causal_dwconv(glu, buf, w, b)
    y = layer_norm(y, ln_g, ln_b)
    return jax.nn.silu(y), new_buf


def trunk_layer(x, h0, ssm_buf, k_cache, v_cache, sc_buf, cc_buf,
                norm_mix, w_in, ssm_conv_w, ssm_conv_b, ssm_dt_bias, ssm_a_log, ssm_d, ssm_norm,
                swa_sinks, sconv_w, cconv_w, cconv_b, cconv_ln_g, cconv_ln_b, w_out,
                norm_ffn, w_gate, w_up, w_down):
    n, L, _ = x.shape
    prompt = k_cache is None
    u = rms_norm(x, norm_mix) @ w_in
    z, xbc, dt_raw, q, k, v, u_sc, u_cc = jnp.split(u, IN_SPLITS, axis=-1)
    ya, ssm_buf_new, h_new = mixer_ssd(z, xbc, dt_raw, ssm_buf, h0, ssm_conv_w, ssm_conv_b, ssm_dt_bias,
                                       ssm_a_log, ssm_d, ssm_norm, CHUNK if prompt else L)
    q = q.reshape(n, L, SWA_KV_HEADS, SWA_GROUP, SWA_HEAD_DIM)
    k = k.reshape(n, L, SWA_KV_HEADS, SWA_HEAD_DIM)
    v = v.reshape(n, L, SWA_KV_HEADS, SWA_HEAD_DIM)
    if prompt:
        yb = swa_prompt(q, k, v, swa_sinks)
        keep = min(WINDOW, L)
        k_new, v_new = k[:, L - keep:], v[:, L - keep:]
    else:
        yb = swa_sample(q, k, v, k_cache, v_cache, swa_sinks)
        k_new, v_new = k, v
    yc, sc_new = mixer_shortconv(u_sc, sc_buf, sconv_w)
    yd, cc_new = mixer_conformer(u_cc, cc_buf, cconv_w, cconv_b, cconv_ln_g, cconv_ln_b)
    mix = jnp.concatenate([ya, yb.astype(x.dtype), yc, yd], axis=-1)
    x = x + mix @ w_out
    hf = rms_norm(x, norm_ffn)
    x = x + (jax.nn.silu(hf @ w_gate) * (hf @ w_up)) @ w_down
    return x, h_new, ssm_buf_new, k_new, v_new, sc_new, cc_new


def setup_inputs(seed: int = 0) -> dict:
    key = jax.random.key(seed)
    ks = jax.random.split(key, 32)
    f32 = jnp.float32

    def nrm(k, shape, s):
        return s * jax.random.normal(k, shape, f32)

    win_cache = min(WINDOW, PAST_LEN)
    dt0 = jnp.exp(jax.random.uniform(ks[10], (DEPTH, SSM_HEADS), f32, math.log(1e-3), math.log(1e-1)))
    return {
        'x_prompt': nrm(ks[0], (BATCH, SEQ, D_MODEL), 1.0),
        'x_sample': nrm(ks[1], (DEC_BATCH, DEC_SEQ, D_MODEL), 1.0),
        'state_ssm': nrm(ks[2], (DEPTH, DEC_BATCH, SSM_HEADS, SSM_HEAD_DIM, SSM_STATE), 0.5),
        'state_ssm_conv': nrm(ks[3], (DEPTH, DEC_BATCH, SSM_CONV - 1, SSM_CONV_DIM), 1.0),
        'cache_swa_k': nrm(ks[4], (DEPTH, DEC_BATCH, win_cache, SWA_KV_HEADS, SWA_HEAD_DIM), 1.0),
        'cache_swa_v': nrm(ks[5], (DEPTH, DEC_BATCH, win_cache, SWA_KV_HEADS, SWA_HEAD_DIM), 1.0),
        'state_sconv': nrm(ks[6], (DEPTH, DEC_BATCH, SC_CONV - 1, SC_WIDTH), 1.0),
        'state_cconv': nrm(ks[7], (DEPTH, DEC_BATCH, CC_CONV - 1, CC_WIDTH), 0.5),
        'norm_mix': 1.0 + nrm(ks[8], (DEPTH, D_MODEL), 0.05),
        'w_in': nrm(ks[9], (DEPTH, D_MODEL, D_IN), D_MODEL ** -0.5),
        'ssm_conv_w': nrm(ks[11], (DEPTH, SSM_CONV, SSM_CONV_DIM), SSM_CONV ** -0.5),
        'ssm_conv_b': nrm(ks[12], (DEPTH, SSM_CONV_DIM), 0.02),
        'ssm_dt_bias': dt0 + jnp.log(-jnp.expm1(-dt0)),
        'ssm_a_log': jnp.log(jax.random.uniform(ks[13], (DEPTH, SSM_HEADS), f32, 1.0, 16.0)),
        'ssm_d': 1.0 + nrm(ks[14], (DEPTH, SSM_HEADS), 0.1),
        'ssm_norm': 1.0 + nrm(ks[15], (DEPTH, SSM_INNER), 0.05),
        'swa_sinks': nrm(ks[16], (DEPTH, SWA_HEADS), 0.5),
        'sconv_w': nrm(ks[17], (DEPTH, SC_CONV, SC_WIDTH), SC_CONV ** -0.5),
        'cconv_w': nrm(ks[18], (DEPTH, CC_CONV, CC_WIDTH), CC_CONV ** -0.5),
        'cconv_b': nrm(ks[19], (DEPTH, CC_WIDTH), 0.02),
        'cconv_ln_g': 1.0 + nrm(ks[20], (DEPTH, CC_WIDTH), 0.05),
        'cconv_ln_b': nrm(ks[21], (DEPTH, CC_WIDTH), 0.02),
        'w_out': nrm(ks[22], (DEPTH, D_MIX, D_MODEL), D_MIX ** -0.5),
        'norm_ffn': 1.0 + nrm(ks[23], (DEPTH, D_MODEL), 0.05),
        'w_gate': nrm(ks[24], (DEPTH, D_MODEL, D_FF), D_MODEL ** -0.5),
        'w_up': nrm(ks[25], (DEPTH, D_MODEL, D_FF), D_MODEL ** -0.5),
        'w_down': nrm(ks[26], (DEPTH, D_FF, D_MODEL), D_FF ** -0.5),
        'norm_final': 1.0 + nrm(ks[27], (D_MODEL,), 0.05),
    }


def reference(x_prompt, x_sample, state_ssm, state_ssm_conv, cache_swa_k, cache_swa_v, state_sconv, state_cconv,
              norm_mix, w_in, ssm_conv_w, ssm_conv_b, ssm_dt_bias, ssm_a_log, ssm_d, ssm_norm, swa_sinks,
              sconv_w, cconv_w, cconv_b, cconv_ln_g, cconv_ln_b, w_out, norm_ffn, w_gate, w_up, w_down,
              norm_final):
    act_dtype = x_prompt.dtype
    xp, xs = x_prompt, x_sample
    nb = xp.shape[0]
    new_p = [[] for _ in range(6)]
    new_s = [[] for _ in range(6)]
    for l in range(DEPTH):
        lw = (norm_mix[l], w_in[l], ssm_conv_w[l], ssm_conv_b[l], ssm_dt_bias[l], ssm_a_log[l], ssm_d[l],
              ssm_norm[l], swa_sinks[l], sconv_w[l], cconv_w[l], cconv_b[l], cconv_ln_g[l], cconv_ln_b[l],
              w_out[l], norm_ffn[l], w_gate[l], w_up[l], w_down[l])
        xp, *sp = trunk_layer(xp,
                              jnp.zeros((nb, SSM_HEADS, SSM_HEAD_DIM, SSM_STATE), act_dtype),
                              jnp.zeros((nb, SSM_CONV - 1, SSM_CONV_DIM), act_dtype),
                              None, None,
                              jnp.zeros((nb, SC_CONV - 1, SC_WIDTH), act_dtype),
                              jnp.zeros((nb, CC_CONV - 1, CC_WIDTH), act_dtype),
                              *lw)
        xs, *ss = trunk_layer(xs, state_ssm[l], state_ssm_conv[l], cache_swa_k[l], cache_swa_v[l],
                              state_sconv[l], state_cconv[l], *lw)
        for i in range(6):
            new_p[i].append(sp[i])
            new_s[i].append(ss[i])
    ssm_p, ssm_conv_p, swa_k_p, swa_v_p, sconv_p, cconv_p = [jnp.stack(a, axis=0) for a in new_p]
    ssm_s, ssm_conv_s, swa_k_s, swa_v_s, sconv_s, cconv_s = [jnp.stack(a, axis=0) for a in new_s]
    y_prompt = rms_norm(xp, norm_final)
    y_sample = rms_norm(xs, norm_final)
    return (y_prompt, y_sample, ssm_p, ssm_s, ssm_conv_p, ssm_conv_s, swa_k_p, swa_k_s, swa_v_p, swa_v_s,
            sconv_p, sconv_s, cconv_p, cconv_s)
```

```cpp
#include <hip/hip_runtime.h>
#include <hip/hip_cooperative_groups.h>
#include <cstdio>
namespace cg = cooperative_groups;

#ifndef ONLY
#define ONLY -1
#endif
#define EN(k) (ONLY < 0 || ONLY == (k))
#ifndef MK_MULTI
#define MK_MULTI 0
#endif

typedef unsigned short bf16_t;
typedef short bf16x8 __attribute__((ext_vector_type(8)));
typedef float f32x4 __attribute__((ext_vector_type(4)));
typedef unsigned u32x4 __attribute__((ext_vector_type(4)));
typedef unsigned u32x2 __attribute__((ext_vector_type(2)));

constexpr int D = 1024, NB = 4, SEQ = 4096, NS = 32, LS = 16, PAST = 1024;
constexpr int MP = NB * SEQ, MS = NS * LS, MT = MP + MS;
constexpr int NU = 2560, DIN = 2564, DFF = 2816, NGU = 2 * DFF;
constexpr int NCI = 256 + NS;
constexpr float EPS = 1e-5f;
constexpr int NTHR = 512;
constexpr int LDS_BYTES = 120 * 1024;
constexpr int NPH = 16;

constexpr size_t O_Y = 0;
constexpr size_t O_SSM_P = (size_t)MT * D;
constexpr size_t O_SSM_S = O_SSM_P + 2 * 4 * 4 * 64 * 128;
constexpr size_t O_SCV_P = O_SSM_S + 2 * 32 * 4 * 64 * 128;
constexpr size_t O_SCV_S = O_SCV_P + 2 * 4 * 3 * 512;
constexpr size_t O_K_P = O_SCV_S + 2 * 32 * 3 * 512;
constexpr size_t O_K_S = O_K_P + 2 * 4 * 128 * 128;
constexpr size_t O_V_P = O_K_S + 2 * 32 * 16 * 128;
constexpr size_t O_V_S = O_V_P + 2 * 4 * 128 * 128;
constexpr size_t O_SC_P = O_V_S + 2 * 32 * 16 * 128;
constexpr size_t O_SC_S = O_SC_P + 2 * 4 * 2 * 256;
constexpr size_t O_CC_P = O_SC_S + 2 * 32 * 2 * 256;
constexpr size_t O_CC_S = O_CC_P + 2 * 4 * 30 * 256;
constexpr size_t O_END = O_CC_S + 2 * 32 * 30 * 256;
static_assert(O_END == 20885504, "output size");

constexpr size_t W_IN_B = (size_t)NU * D * 2, W_OUT_B = (size_t)D * D * 2, W_GU_B = (size_t)NGU * D * 2, W_DN_B = (size_t)D * DFF * 2;
constexpr size_t WS_WIN = 0;
constexpr size_t WS_WOUT = WS_WIN + 2 * W_IN_B;
constexpr size_t WS_WGU = WS_WOUT + 2 * W_OUT_B;
constexpr size_t WS_WDN = WS_WGU + 2 * W_GU_B;
constexpr size_t WS_WDT = WS_WDN + 2 * W_DN_B;
constexpr size_t WS_XB = WS_WDT + 2 * 4 * 1024 * 4;
constexpr size_t WS_PART = WS_XB + (size_t)MT * D * 2;
constexpr size_t WS_DT = WS_PART + (size_t)MT * 8 * 4;
constexpr size_t WS_AC = WS_DT + (size_t)MT * 4 * 4;
constexpr size_t WS_DEC = WS_AC + (size_t)MT * 4 * 4;
constexpr size_t WS_U = WS_DEC + 4096;
constexpr size_t WS_XC = WS_U + (size_t)MT * NU * 2;
constexpr size_t WS_S = WS_XC + (size_t)MT * 512 * 2;
constexpr size_t WS_MIX = WS_S + (size_t)256 * 4 * 64 * 128 * 4;
constexpr size_t WS_END = WS_MIX + (size_t)MT * D * 2;
static_assert(WS_END <= (size_t)256 * 1024 * 1024, "workspace too large");
static_assert((size_t)MT * DFF * 2 <= (WS_S - WS_U), "hb alias");

struct Params {
    const float* x_prompt; const float* x_sample; const float* state_ssm; const float* state_ssm_conv;
    const float* cache_k; const float* cache_v; const float* state_sconv; const float* state_cconv;
    const float* norm_mix; const float* w_in; const float* ssm_conv_w; const float* ssm_conv_b;
    const float* ssm_dt_bias; const float* ssm_a_log; const float* ssm_d; const float* ssm_norm;
    const float* sinks; const float* sconv_w; const float* cconv_w; const float* cconv_b;
    const float* cconv_ln_g; const float* cconv_ln_b; const float* w_out; const float* norm_ffn;
    const float* w_gate; const float* w_up; const float* w_down; const float* norm_final;
    float* out; unsigned char* ws;
};

__device__ __forceinline__ unsigned pack_bf16(float lo, float hi) { unsigned r; asm("v_cvt_pk_bf16_f32 %0, %1, %2" : "=v"(r) : "v"(lo), "v"(hi)); return r; }
__device__ __forceinline__ bf16_t f2bf(float f) { return (bf16_t)(pack_bf16(f, 0.f) & 0xffffu); }
__device__ __forceinline__ float bf2f(bf16_t h) { return __uint_as_float(((unsigned)h) << 16); }
__device__ __forceinline__ float bflo(unsigned u) { return __uint_as_float(u << 16); }
__device__ __forceinline__ float bfhi(unsigned u) { return __uint_as_float(u & 0xffff0000u); }
__device__ __forceinline__ f32x4 mfma16(bf16x8 a, bf16x8 b, f32x4 c) { return __builtin_amdgcn_mfma_f32_16x16x32_bf16(a, b, c, 0, 0, 0); }
__device__ __forceinline__ int opaque(int x) { asm volatile("" : "+v"(x)); return x; }
__device__ __forceinline__ float sigmoidf_(float x) { return 1.f / (1.f + __expf(-x)); }
__device__ __forceinline__ float siluf_(float x) { return x * sigmoidf_(x); }
__device__ __forceinline__ float wave_sum(float v) {
#pragma unroll
    for (int o = 32; o >= 1; o >>= 1) v += __shfl_xor(v, o);
    return v;
}
__device__ __forceinline__ float rstd_row(const float* part, int row) {
    const f32x4 a = *(const f32x4*)(part + (size_t)row * 8), b = *(const f32x4*)(part + (size_t)row * 8 + 4);
    const float ss = (a[0] + a[1]) + (a[2] + a[3]) + (b[0] + b[1]) + (b[2] + b[3]);
    return rsqrtf(ss * (1.f / 1024.f) + EPS);
}
__device__ __forceinline__ u32x4 pack8(const float* v) { u32x4 r; r[0] = pack_bf16(v[0], v[1]); r[1] = pack_bf16(v[2], v[3]); r[2] = pack_bf16(v[4], v[5]); r[3] = pack_bf16(v[6], v[7]); return r; }
__device__ __forceinline__ u32x4 load8f_bf(const float* src) { const f32x4 a = *(const f32x4*)src, b = *(const f32x4*)(src + 4); u32x4 r; r[0] = pack_bf16(a[0], a[1]); r[1] = pack_bf16(a[2], a[3]); r[2] = pack_bf16(b[0], b[1]); r[3] = pack_bf16(b[2], b[3]); return r; }

struct Item { int r0, L, t0, b, c, s; bool samp; };
__device__ __forceinline__ Item decode_item(int ci) {
    Item it;
    if (ci < 256) { it.samp = false; it.b = ci >> 6; it.c = ci & 63; it.s = 0; it.r0 = ci * 64; it.L = 64; it.t0 = it.c * 64; }
    else { it.samp = true; it.s = ci - 256; it.b = 0; it.c = 0; it.r0 = MP + it.s * LS; it.L = LS; it.t0 = 0; }
    return it;
}

template <class Epi>
__device__ __forceinline__ void gemm_phase(const bf16_t* __restrict__ A, const bf16_t* __restrict__ Bt, int M, int N, int K, const Epi& epi, unsigned char* smem) {
    const int tid = opaque(threadIdx.x), lane = tid & 63, w = tid >> 6, wm = w >> 1, wn = w & 1, fr = lane & 15, fq = lane >> 4;
    const int nM = M / 256, nN = N / 256, ntile = nM * nN, nk = K / 64;
    for (int tile = blockIdx.x; tile < ntile; tile += gridDim.x) {
        const int pn = tile % nN, pm = tile / nN;
        f32x4 acc[4][8];
#pragma unroll
        for (int i = 0; i < 4; ++i)
#pragma unroll
            for (int j = 0; j < 8; ++j) acc[i][j] = (f32x4){0.f, 0.f, 0.f, 0.f};
        const int srow = tid >> 3, spart = tid & 7;
        const bf16_t* ag = A + (size_t)(pm * 256 + srow) * K + spart * 8;
        const bf16_t* bg = Bt + (size_t)(pn * 256 + srow) * K + spart * 8;
        const int lo = (spart >> 2) * 16384 + srow * 64 + (spart & 3) * 16;
        u32x4 ra[4], rb[4];
#pragma unroll
        for (int i = 0; i < 4; ++i) { ra[i] = *(const u32x4*)(ag + (size_t)i * 64 * K); rb[i] = *(const u32x4*)(bg + (size_t)i * 64 * K); }
        __syncthreads();
#pragma unroll
        for (int i = 0; i < 4; ++i) { *(u32x4*)(smem + lo + i * 4096) = ra[i]; *(u32x4*)(smem + 32768 + lo + i * 4096) = rb[i]; }
        __syncthreads();
        for (int ks = 0; ks < nk; ++ks) {
            if (ks + 1 < nk) {
#pragma unroll
                for (int i = 0; i < 4; ++i) { ra[i] = *(const u32x4*)(ag + (size_t)i * 64 * K + (ks + 1) * 64); rb[i] = *(const u32x4*)(bg + (size_t)i * 64 * K + (ks + 1) * 64); }
            }
#pragma unroll
            for (int kk = 0; kk < 2; ++kk) {
                bf16x8 af[4];
#pragma unroll
                for (int i = 0; i < 4; ++i) af[i] = *(const bf16x8*)(smem + kk * 16384 + (wm * 64 + i * 16 + fr) * 64 + fq * 16);
#pragma unroll
                for (int jh = 0; jh < 2; ++jh) {
                    bf16x8 bfv[4];
#pragma unroll
                    for (int j = 0; j < 4; ++j) bfv[j] = *(const bf16x8*)(smem + 32768 + kk * 16384 + (wn * 128 + (jh * 4 + j) * 16 + fr) * 64 + fq * 16);
#pragma unroll
                    for (int i = 0; i < 4; ++i)
#pragma unroll
                        for (int j = 0; j < 4; ++j) acc[i][jh * 4 + j] = mfma16(bfv[j], af[i], acc[i][jh * 4 + j]);
                }
            }
            __syncthreads();
            if (ks + 1 < nk) {
#pragma unroll
                for (int i = 0; i < 4; ++i) { *(u32x4*)(smem + lo + i * 4096) = ra[i]; *(u32x4*)(smem + 32768 + lo + i * 4096) = rb[i]; }
                __syncthreads();
            }
        }
        epi(acc, pm * 256 + wm * 64 + fr, pn * 256 + wn * 128 + fq * 4, pn * 2 + wn);
    }
}

struct EpiU {
    bf16_t* u; const float* part;
    __device__ __forceinline__ void operator()(const f32x4 (&acc)[4][8], int row0, int col0, int) const {
#pragma unroll
        for (int i = 0; i < 4; ++i) {
            const int row = row0 + 16 * i; const float rs = rstd_row(part, row);
            bf16_t* dst = u + (size_t)row * NU + col0;
#pragma unroll
            for (int j = 0; j < 8; ++j) { u32x2 v; v[0] = pack_bf16(acc[i][j][0] * rs, acc[i][j][1] * rs); v[1] = pack_bf16(acc[i][j][2] * rs, acc[i][j][3] * rs); *(u32x2*)(dst + 16 * j) = v; }
        }
    }
};
struct EpiRes {
    float* X; bf16_t* xb; float* part;
    __device__ __forceinline__ void operator()(const f32x4 (&acc)[4][8], int row0, int col0, int slot) const {
#pragma unroll
        for (int i = 0; i < 4; ++i) {
            const int row = row0 + 16 * i; float ss = 0.f;
            float* xr = X + (size_t)row * D + col0; bf16_t* br = xb + (size_t)row * D + col0;
#pragma unroll
            for (int j = 0; j < 8; ++j) {
                f32x4 v = *(const f32x4*)(xr + 16 * j); v += acc[i][j];
                *(f32x4*)(xr + 16 * j) = v;
                u32x2 pk; pk[0] = pack_bf16(v[0], v[1]); pk[1] = pack_bf16(v[2], v[3]); *(u32x2*)(br + 16 * j) = pk;
                ss += v[0] * v[0] + v[1] * v[1] + v[2] * v[2] + v[3] * v[3];
            }
            ss += __shfl_xor(ss, 16); ss += __shfl_xor(ss, 32);
            if ((threadIdx.x & 63) < 16) part[(size_t)row * 8 + slot] = ss;
        }
    }
};
struct EpiGlu {
    bf16_t* hb; const float* part;
    __device__ __forceinline__ void operator()(const f32x4 (&acc)[4][8], int row0, int col0, int) const {
        const int ff0 = (col0 >> 5) * 16 + (col0 & 15);
#pragma unroll
        for (int i = 0; i < 4; ++i) {
            const int row = row0 + 16 * i; const float rs = rstd_row(part, row);
            bf16_t* dst = hb + (size_t)row * DFF + ff0;
#pragma unroll
            for (int j = 0; j < 4; ++j) {
                float h[4];
#pragma unroll
                for (int e = 0; e < 4; ++e) { const float g = acc[i][2 * j][e] * rs, uu = acc[i][2 * j + 1][e] * rs; h[e] = siluf_(g) * uu; }
                u32x2 pk; pk[0] = pack_bf16(h[0], h[1]); pk[1] = pack_bf16(h[2], h[3]); *(u32x2*)(dst + 16 * j) = pk;
            }
        }
    }
};

__device__ __forceinline__ void prep_tile(const Params& p, int it, unsigned char* smem) {
    const int tid = opaque(threadIdx.x);
    const int l = it / 3009; int r = it % 3009;
    if (r == 3008) {
        float* wdt = (float*)(p.ws + WS_WDT) + (size_t)l * 4096;
        for (int e = tid; e < 4096; e += NTHR) { const int h = e >> 10, k = e & 1023; wdt[e] = p.norm_mix[l * D + k] * p.w_in[((size_t)l * D + k) * DIN + 768 + h]; }
        return;
    }
    int kind, tn, tk, K;
    if (r < 640) { kind = 0; tn = r >> 4; tk = r & 15; K = 1024; }
    else if (r < 896) { r -= 640; kind = 1; tn = r >> 4; tk = r & 15; K = 1024; }
    else if (r < 2304) { r -= 896; kind = 2; tn = r >> 4; tk = r & 15; K = 1024; }
    else { r -= 2304; kind = 3; tn = r / 44; tk = r % 44; K = DFF; }
    float* tile = (float*)smem;
    const int n0 = tn * 64, k0 = tk * 64;
    __syncthreads();
#pragma unroll
    for (int i = 0; i < 8; ++i) {
        const int idx = tid + NTHR * i, kk = idx >> 6, nn = idx & 63, n = n0 + nn, k = k0 + kk;
        float v;
        if (kind == 0) v = p.w_in[((size_t)l * D + k) * DIN + (n < 768 ? n : n + 4)] * p.norm_mix[l * D + k];
        else if (kind == 1) v = p.w_out[((size_t)l * D + k) * D + n];
        else if (kind == 2) { const int col = (n >> 5) * 16 + (n & 15); const float* src = ((n >> 4) & 1) ? p.w_up : p.w_gate; v = src[((size_t)l * D + k) * DFF + col] * p.norm_ffn[l * D + k]; }
        else v = p.w_down[((size_t)l * DFF + k) * D + n];
        tile[nn * 65 + kk] = v;
    }
    __syncthreads();
    bf16_t* dst = (bf16_t*)(p.ws + (kind == 0 ? WS_WIN + l * W_IN_B : kind == 1 ? WS_WOUT + l * W_OUT_B : kind == 2 ? WS_WGU + l * W_GU_B : WS_WDN + l * W_DN_B));
#pragma unroll
    for (int i = 0; i < 4; ++i) {
        const int idx = tid + NTHR * i, nn = idx >> 5, kp = idx & 31;
        *(unsigned*)(dst + (size_t)(n0 + nn) * K + k0 + 2 * kp) = pack_bf16(tile[nn * 65 + 2 * kp], tile[nn * 65 + 2 * kp + 1]);
    }
}
__device__ __forceinline__ void init_rows(const Params& p, int it) {
    const int tid = opaque(threadIdx.x), lane = tid & 63, w = tid >> 6;
    const int row = it * 8 + w;
    const float* src = row < MP ? p.x_prompt + (size_t)row * D : p.x_sample + (size_t)(row - MP) * D;
    float* X = p.out + (size_t)row * D; bf16_t* xb = (bf16_t*)(p.ws + WS_XB) + (size_t)row * D;
    float ss = 0.f;
#pragma unroll
    for (int i = 0; i < 4; ++i) {
        const int c = i * 256 + lane * 4;
        const f32x4 v = *(const f32x4*)(src + c);
        *(f32x4*)(X + c) = v;
        u32x2 pk; pk[0] = pack_bf16(v[0], v[1]); pk[1] = pack_bf16(v[2], v[3]); *(u32x2*)(xb + c) = pk;
        ss += v[0] * v[0] + v[1] * v[1] + v[2] * v[2] + v[3] * v[3];
    }
    ss = wave_sum(ss);
    if (lane < 8) ((float*)(p.ws + WS_PART))[(size_t)row * 8 + lane] = lane == 0 ? ss : 0.f;
}

__device__ __forceinline__ void swa_item(const Params& p, int l, int ci, int kvh, unsigned char* smem) {
    const int tid = opaque(threadIdx.x), lane = tid & 63, w = tid >> 6, fr = lane & 15, fq = lane >> 4;
    const Item it = decode_item(ci);
    bf16_t* Ks = (bf16_t*)smem;
    bf16_t* Vt = (bf16_t*)(smem + 27648);
    bf16_t* Ps = (bf16_t*)(smem + 27648 + 25600);
    float* invs = (float*)(smem + 27648 + 25600 + 51200);
    const bf16_t* u = (const bf16_t*)(p.ws + WS_U);
    bf16_t* mix = (bf16_t*)(p.ws + WS_MIX);
    const int kbase = it.samp ? (PAST - 128) : (it.t0 - 128);
    const int qbase = it.samp ? PAST : it.t0;
    const int nkeys = it.samp ? 144 : 192;
#pragma unroll 1
    for (int idx = tid; idx < 1536; idx += NTHR) {
        const int key = idx >> 3, part = idx & 7;
        u32x4 kv = (u32x4){0u, 0u, 0u, 0u}, vv = (u32x4){0u, 0u, 0u, 0u};
        if (!it.samp) {
            const int tg = it.t0 - 128 + key;
            if (tg >= 0) { const bf16_t* src = u + (size_t)(it.b * SEQ + tg) * NU + kvh * 64 + part * 8; kv = *(const u32x4*)(src + 1024); vv = *(const u32x4*)(src + 1152); }
        } else if (key < 128) {
            const size_t o = ((((size_t)l * NS + it.s) * 128 + key) * 2 + kvh) * 64 + part * 8;
            kv = load8f_bf(p.cache_k + o); vv = load8f_bf(p.cache_v + o);
        } else if (key < 144) {
            const bf16_t* src = u + (size_t)(MP + it.s * LS + key - 128) * NU + kvh * 64 + part * 8; kv = *(const u32x4*)(src + 1024); vv = *(const u32x4*)(src + 1152);
        }
        *(u32x4*)(Ks + key * 72 + part * 8) = kv;
#pragma unroll
        for (int e = 0; e < 4; ++e) { Vt[(part * 8 + 2 * e) * 200 + key] = (bf16_t)(vv[e] & 0xffffu); Vt[(part * 8 + 2 * e + 1) * 200 + key] = (bf16_t)(vv[e] >> 16); }
    }
    __syncthreads();
    const int g = w >> 2, qt = w & 3, h = kvh * 2 + g;
    const bool active = qt * 16 < it.L;
    if (active) {
        f32x4 sacc[12];
#pragma unroll
        for (int kt = 0; kt < 12; ++kt) sacc[kt] = (f32x4){0.f, 0.f, 0.f, 0.f};
        const bf16_t* qsrc = u + (size_t)(it.r0 + qt * 16 + fr) * NU + 768 + h * 64 + fq * 8;
        bf16x8 qf[2]; qf[0] = *(const bf16x8*)qsrc; qf[1] = *(const bf16x8*)(qsrc + 32);
#pragma unroll
        for (int kt = 0; kt < 12; ++kt)
#pragma unroll
            for (int ks = 0; ks < 2; ++ks) { const bf16x8 kf = *(const bf16x8*)(Ks + (kt * 16 + fr) * 72 + ks * 32 + fq * 8); sacc[kt] = mfma16(kf, qf[ks], sacc[kt]); }
        const float slope = exp2f(-2.f * (float)(h + 1)), sink = p.sinks[l * 4 + h];
        const int qpos = qbase + qt * 16 + fr;
        float m = sink;
#pragma unroll
        for (int kt = 0; kt < 12; ++kt)
#pragma unroll
            for (int r = 0; r < 4; ++r) {
                const int key = kt * 16 + fq * 4 + r, kpos = kbase + key;
                const bool valid = (kpos >= 0) && (key < nkeys);
                float sv = sacc[kt][r] * 0.125f - slope * fabsf((float)(qpos - kpos));
                sv = valid ? sv : -INFINITY; sacc[kt][r] = sv; m = fmaxf(m, sv);
            }
        m = fmaxf(m, __shfl_xor(m, 16)); m = fmaxf(m, __shfl_xor(m, 32));
        float sum = 0.f;
#pragma unroll
        for (int kt = 0; kt < 12; ++kt)
#pragma unroll
            for (int r = 0; r < 4; ++r) { const float pv = __expf(sacc[kt][r] - m); sacc[kt][r] = pv; sum += pv; }
        sum += __shfl_xor(sum, 16); sum += __shfl_xor(sum, 32);
        sum += __expf(sink - m);
        bf16_t* prow = Ps + (g * 64 + qt * 16 + fr) * 200 + fq * 4;
#pragma unroll
        for (int kt = 0; kt < 12; ++kt) { u32x2 pk; pk[0] = pack_bf16(sacc[kt][0], sacc[kt][1]); pk[1] = pack_bf16(sacc[kt][2], sacc[kt][3]); *(u32x2*)(prow + kt * 16) = pk; }
        if (fq == 0) invs[w * 16 + fr] = 1.f / sum;
    }
    __syncthreads();
    if (active) {
        f32x4 o[4];
#pragma unroll
        for (int dt = 0; dt < 4; ++dt) o[dt] = (f32x4){0.f, 0.f, 0.f, 0.f};
#pragma unroll
        for (int ks = 0; ks < 6; ++ks) {
            const bf16x8 pf = *(const bf16x8*)(Ps + (g * 64 + qt * 16 + fr) * 200 + ks * 32 + fq * 8);
#pragma unroll
            for (int dt = 0; dt < 4; ++dt) { const bf16x8 vf = *(const bf16x8*)(Vt + (dt * 16 + fr) * 200 + ks * 32 + fq * 8); o[dt] = mfma16(pf, vf, o[dt]); }
        }
#pragma unroll
        for (int r = 0; r < 4; ++r) {
            const int q = qt * 16 + fq * 4 + r; const float iv = invs[w * 16 + fq * 4 + r];
            bf16_t* dst = mix + (size_t)(it.r0 + q) * D + 256 + h * 64 + fr;
#pragma unroll
            for (int dt = 0; dt < 4; ++dt) dst[dt * 16] = f2bf(o[dt][r] * iv);
        }
    }
    __syncthreads();
}

__device__ __forceinline__ void ssd1_item(const Params& p, int l, int ci, unsigned char* smem) {
    const int tid = opaque(threadIdx.x), lane = tid & 63, w = tid >> 6, fr = lane & 15, fq = lane >> 4;
    const Item it = decode_item(ci);
    bf16_t* xwT = (bf16_t*)smem;
    bf16_t* BT = (bf16_t*)(smem + 36864);
    float* dts = (float*)(smem + 55296);
    float* acs = dts + 256;
    float* wts = acs + 256;
    const bf16_t* u = (const bf16_t*)(p.ws + WS_U);
    const bf16_t* xb = (const bf16_t*)(p.ws + WS_XB);
    const float* part = (const float*)(p.ws + WS_PART);
    const float* wdt = (const float*)(p.ws + WS_WDT) + (size_t)l * 4096;
    bf16_t* xc = (bf16_t*)(p.ws + WS_XC);
#pragma unroll 1
    for (int tt = 0; tt < 8; ++tt) {
        const int t = w * 8 + tt;
        float d4[4] = {0.f, 0.f, 0.f, 0.f};
        if (t < it.L) {
            const bf16_t* xr = xb + (size_t)(it.r0 + t) * D + lane * 16;
            const u32x4 x0 = *(const u32x4*)xr, x1 = *(const u32x4*)(xr + 8);
            float xf[16];
#pragma unroll
            for (int e = 0; e < 4; ++e) { xf[2 * e] = bflo(x0[e]); xf[2 * e + 1] = bfhi(x0[e]); xf[8 + 2 * e] = bflo(x1[e]); xf[8 + 2 * e + 1] = bfhi(x1[e]); }
#pragma unroll
            for (int h = 0; h < 4; ++h) {
                const float* wp = wdt + h * 1024 + lane * 16; float a = 0.f;
#pragma unroll
                for (int e4 = 0; e4 < 4; ++e4) { const f32x4 wv = *(const f32x4*)(wp + 4 * e4); a += xf[4 * e4] * wv[0] + xf[4 * e4 + 1] * wv[1] + xf[4 * e4 + 2] * wv[2] + xf[4 * e4 + 3] * wv[3]; }
                a = wave_sum(a);
                const float raw = a * rstd_row(part, it.r0 + t) + p.ssm_dt_bias[l * 4 + h];
                d4[h] = raw > 20.f ? raw : log1pf(__expf(raw));
            }
        }
        if (lane == 0) { dts[t * 4 + 0] = d4[0]; dts[t * 4 + 1] = d4[1]; dts[t * 4 + 2] = d4[2]; dts[t * 4 + 3] = d4[3]; }
    }
    __syncthreads();
    if (tid < 4) {
        const int h = tid; const float A = -__expf(p.ssm_a_log[l * 4 + h]); float run = 0.f;
        float* dtg = (float*)(p.ws + WS_DT); float* acg = (float*)(p.ws + WS_AC);
        for (int t = 0; t < 64; ++t) {
            run += dts[t * 4 + h] * A; acs[t * 4 + h] = run;
            if (t < it.L) { dtg[(size_t)(it.r0 + t) * 4 + h] = dts[t * 4 + h]; acg[(size_t)(it.r0 + t) * 4 + h] = run; }
        }
        for (int t = 0; t < 64; ++t) wts[t * 4 + h] = __expf(run - acs[t * 4 + h]) * dts[t * 4 + h];
        if (!it.samp) ((float*)(p.ws + WS_DEC))[ci * 4 + h] = __expf(run);
    }
    __syncthreads();
    {
        const int ch = tid;
        const float w0 = p.ssm_conv_w[(l * 4 + 0) * 512 + ch], w1 = p.ssm_conv_w[(l * 4 + 1) * 512 + ch], w2 = p.ssm_conv_w[(l * 4 + 2) * 512 + ch], w3 = p.ssm_conv_w[(l * 4 + 3) * 512 + ch];
        const float bias = p.ssm_conv_b[l * 512 + ch];
        float xm3, xm2, xm1;
        if (it.samp) {
            const float* sb = p.state_ssm_conv + ((size_t)(l * NS + it.s) * 3) * 512 + ch;
            xm3 = sb[0]; xm2 = sb[512]; xm1 = sb[1024];
        } else if (it.t0 > 0) {
            const bf16_t* ub = u + (size_t)(it.r0 - 3) * NU + 256 + ch;
            xm3 = bf2f(ub[0]); xm2 = bf2f(ub[NU]); xm1 = bf2f(ub[2 * NU]);
        } else { xm3 = 0.f; xm2 = 0.f; xm1 = 0.f; }
        const int hh = ch >> 6;
        for (int t = 0; t < 64; ++t) {
            float v = 0.f;
            if (t < it.L) {
                const float xcur = bf2f(u[(size_t)(it.r0 + t) * NU + 256 + ch]);
                const float y = bias + w0 * xm3 + w1 * xm2 + w2 * xm1 + w3 * xcur;
                v = siluf_(y); xm3 = xm2; xm2 = xm1; xm1 = xcur;
                xc[(size_t)(it.r0 + t) * 512 + ch] = f2bf(v);
            }
            if (ch < 256) xwT[ch * 72 + t] = f2bf(v * wts[t * 4 + hh]);
            else if (ch < 384) BT[(ch - 256) * 72 + t] = f2bf(v);
        }
    }
    __syncthreads();
    {
        const int h = w >> 1, ph = w & 1;
        f32x4 acc[2][8];
#pragma unroll
        for (int i = 0; i < 2; ++i)
#pragma unroll
            for (int j = 0; j < 8; ++j) acc[i][j] = (f32x4){0.f, 0.f, 0.f, 0.f};
#pragma unroll
        for (int ks = 0; ks < 2; ++ks) {
            bf16x8 xf[2];
#pragma unroll
            for (int pt = 0; pt < 2; ++pt) xf[pt] = *(const bf16x8*)(xwT + (h * 64 + ph * 32 + pt * 16 + fr) * 72 + ks * 32 + fq * 8);
#pragma unroll
            for (int nt = 0; nt < 8; ++nt) {
                const bf16x8 bfr = *(const bf16x8*)(BT + (nt * 16 + fr) * 72 + ks * 32 + fq * 8);
#pragma unroll
                for (int pt = 0; pt < 2; ++pt) acc[pt][nt] = mfma16(xf[pt], bfr, acc[pt][nt]);
            }
        }
        const float dec = __expf(acs[63 * 4 + h]);
#pragma unroll
        for (int pt = 0; pt < 2; ++pt)
#pragma unroll
            for (int nt = 0; nt < 8; ++nt)
#pragma unroll
                for (int r = 0; r < 4; ++r) {
                    const int pp = ph * 32 + pt * 16 + fq * 4 + r, n = nt * 16 + fr;
                    if (!it.samp) ((float*)(p.ws + WS_S))[(((size_t)ci * 4 + h) * 64 + pp) * 128 + n] = acc[pt][nt][r];
                    else { const size_t o = (((size_t)(l * NS + it.s) * 4 + h) * 64 + pp) * 128 + n; p.out[O_SSM_S + o] = dec * p.state_ssm[o] + acc[pt][nt][r]; }
                }
    }
    __syncthreads();
}

__device__ __forceinline__ void ssd3_item(const Params& p, int l, int ci, unsigned char* smem) {
    const int tid = opaque(threadIdx.x), lane = tid & 63, w = tid >> 6, fr = lane & 15, fq = lane >> 4;
    const Item it = decode_item(ci);
    bf16_t* xT = (bf16_t*)smem;
    bf16_t* Bm = (bf16_t*)(smem + 36864);
    bf16_t* Cm = (bf16_t*)(smem + 54272);
    bf16_t* G = (bf16_t*)(smem + 71680);
    float* yg = (float*)(smem + 36864);
    float* dts = (float*)(smem + 108544);
    float* acs = dts + 256;
    const bf16_t* u = (const bf16_t*)(p.ws + WS_U);
    const bf16_t* xc = (const bf16_t*)(p.ws + WS_XC);
    bf16_t* mix = (bf16_t*)(p.ws + WS_MIX);
#pragma unroll 1
    for (int idx = tid; idx < 4096; idx += NTHR) {
        const int t = idx >> 6, part = idx & 63;
        u32x4 v = (u32x4){0u, 0u, 0u, 0u};
        if (t < it.L) v = *(const u32x4*)(xc + (size_t)(it.r0 + t) * 512 + part * 8);
        if (part < 32) {
#pragma unroll
            for (int e = 0; e < 4; ++e) { xT[(part * 8 + 2 * e) * 72 + t] = (bf16_t)(v[e] & 0xffffu); xT[(part * 8 + 2 * e + 1) * 72 + t] = (bf16_t)(v[e] >> 16); }
        } else if (part < 48) *(u32x4*)(Bm + t * 136 + (part - 32) * 8) = v;
        else *(u32x4*)(Cm + t * 136 + (part - 48) * 8) = v;
    }
    if (tid < 256) {
        const int t = tid >> 2;
        dts[tid] = t < it.L ? ((const float*)(p.ws + WS_DT))[(size_t)it.r0 * 4 + tid] : 0.f;
        acs[tid] = t < it.L ? ((const float*)(p.ws + WS_AC))[(size_t)it.r0 * 4 + tid] : 0.f;
    }
    __syncthreads();
    {
        const int itl = w & 3, jh = w >> 2;
        f32x4 cb[2]; cb[0] = (f32x4){0.f, 0.f, 0.f, 0.f}; cb[1] = cb[0];
#pragma unroll
        for (int ks = 0; ks < 4; ++ks) {
            const bf16x8 cf = *(const bf16x8*)(Cm + (itl * 16 + fr) * 136 + ks * 32 + fq * 8);
#pragma unroll
            for (int jj = 0; jj < 2; ++jj) { const bf16x8 bfr = *(const bf16x8*)(Bm + ((jh * 2 + jj) * 16 + fr) * 136 + ks * 32 + fq * 8); cb[jj] = mfma16(bfr, cf, cb[jj]); }
        }
        const int i = itl * 16 + fr;
#pragma unroll
        for (int h = 0; h < 4; ++h) {
            const float ai = acs[i * 4 + h];
#pragma unroll
            for (int jj = 0; jj < 2; ++jj) {
                const int j0 = (jh * 2 + jj) * 16 + fq * 4;
                float gv[4];
#pragma unroll
                for (int r = 0; r < 4; ++r) { const int j = j0 + r; gv[r] = (j <= i) ? cb[jj][r] * __expf(ai - acs[j * 4 + h]) * dts[j * 4 + h] : 0.f; }
                u32x2 pk; pk[0] = pack_bf16(gv[0], gv[1]); pk[1] = pack_bf16(gv[2], gv[3]);
                *(u32x2*)(G + (h * 64 + i) * 72 + j0) = pk;
            }
        }
    }
    __syncthreads();
    const int h = w >> 1, ih = w & 1;
    f32x4 yi[2][4], ye[2][4];
#pragma unroll
    for (int a = 0; a < 2; ++a)
#pragma unroll
        for (int b = 0; b < 4; ++b) { yi[a][b] = (f32x4){0.f, 0.f, 0.f, 0.f}; ye[a][b] = yi[a][b]; }
#pragma unroll
    for (int ks = 0; ks < 2; ++ks) {
        bf16x8 gf[2];
#pragma unroll
        for (int a = 0; a < 2; ++a) gf[a] = *(const bf16x8*)(G + (h * 64 + (ih * 2 + a) * 16 + fr) * 72 + ks * 32 + fq * 8);
#pragma unroll
        for (int pt = 0; pt < 4; ++pt) {
            const bf16x8 xf = *(const bf16x8*)(xT + (h * 64 + pt * 16 + fr) * 72 + ks * 32 + fq * 8);
#pragma unroll
            for (int a = 0; a < 2; ++a) yi[a][pt] = mfma16(gf[a], xf, yi[a][pt]);
        }
    }
    const float* hs = it.samp ? p.state_ssm + ((size_t)(l * NS + it.s) * 4 + h) * 8192 : (const float*)(p.ws + WS_S) + ((size_t)ci * 4 + h) * 8192;
#pragma unroll 1
    for (int ks = 0; ks < 4; ++ks) {
        bf16x8 cf[2];
#pragma unroll
        for (int a = 0; a < 2; ++a) cf[a] = *(const bf16x8*)(Cm + ((ih * 2 + a) * 16 + fr) * 136 + ks * 32 + fq * 8);
#pragma unroll
        for (int pt = 0; pt < 4; ++pt) {
            const u32x4 hv = load8f_bf(hs + (size_t)(pt * 16 + fr) * 128 + ks * 32 + fq * 8);
            const bf16x8 hf = __builtin_bit_cast(bf16x8, hv);
#pragma unroll
            for (int a = 0; a < 2; ++a) ye[a][pt] = mfma16(cf[a], hf, ye[a][pt]);
        }
    }
    const float dsk = p.ssm_d[l * 4 + h];
#pragma unroll
    for (int a = 0; a < 2; ++a)
#pragma unroll
        for (int r = 0; r < 4; ++r) {
            const int i = (ih * 2 + a) * 16 + fq * 4 + r; const float ea = __expf(acs[i * 4 + h]);
#pragma unroll
            for (int pt = 0; pt < 4; ++pt) {
                const int pp = pt * 16 + fr;
                const float xv = bf2f(xT[(h * 64 + pp) * 72 + i]);
                const float zv = i < it.L ? bf2f(u[(size_t)(it.r0 + i) * NU + h * 64 + pp]) : 0.f;
                yi[a][pt][r] = (yi[a][pt][r] + ea * ye[a][pt][r] + dsk * xv) * siluf_(zv);
            }
        }
    __syncthreads();
#pragma unroll
    for (int a = 0; a < 2; ++a)
#pragma unroll
        for (int r = 0; r < 4; ++r) {
            const int i = (ih * 2 + a) * 16 + fq * 4 + r;
#pragma unroll
            for (int pt = 0; pt < 4; ++pt) yg[i * 256 + h * 64 + pt * 16 + fr] = yi[a][pt][r];
        }
    __syncthreads();
#pragma unroll 1
    for (int tt = 0; tt < 8; ++tt) {
        const int t = w * 8 + tt;
        if (t < it.L) {
            const f32x4 v = *(const f32x4*)(yg + t * 256 + lane * 4);
            const float ss = wave_sum(v[0] * v[0] + v[1] * v[1] + v[2] * v[2] + v[3] * v[3]);
            const float rs = rsqrtf(ss * (1.f / 256.f) + EPS);
            const f32x4 gn = *(const f32x4*)(p.ssm_norm + l * 256 + lane * 4);
            u32x2 pk; pk[0] = pack_bf16(v[0] * rs * gn[0], v[1] * rs * gn[1]); pk[1] = pack_bf16(v[2] * rs * gn[2], v[3] * rs * gn[3]);
            *(u32x2*)(mix + (size_t)(it.r0 + t) * D + lane * 4) = pk;
        }
    }
    __syncthreads();
}

__device__ __forceinline__ void sconv_item(const Params& p, int l, int ci) {
    const int tid = opaque(threadIdx.x), ch = tid & 255, th = tid >> 8;
    const Item it = decode_item(ci);
    const bf16_t* u = (const bf16_t*)(p.ws + WS_U);
    bf16_t* mix = (bf16_t*)(p.ws + WS_MIX);
    const float w0 = p.sconv_w[(l * 3 + 0) * 256 + ch], w1 = p.sconv_w[(l * 3 + 1) * 256 + ch], w2 = p.sconv_w[(l * 3 + 2) * 256 + ch];
    const int nt = it.L / 2, ts = th * nt;
    float pm[2];
#pragma unroll
    for (int k = 0; k < 2; ++k) {
        const int tl = ts - 2 + k; float v = 0.f;
        if (tl >= 0 || (!it.samp && it.t0 + tl >= 0)) { const bf16_t* ur = u + (size_t)(it.r0 + tl) * NU + ch; v = bf2f(ur[1536]) * bf2f(ur[1792]); }
        else if (it.samp) v = p.state_sconv[((size_t)(l * NS + it.s) * 2 + (tl + 2)) * 256 + ch];
        pm[k] = v;
    }
    const bool wr_state = it.samp || it.c == 63;
    float* sdst = it.samp ? p.out + O_SC_S + (size_t)(l * NS + it.s) * 512 + ch : p.out + O_SC_P + (size_t)(l * NB + it.b) * 512 + ch;
    for (int t = ts; t < ts + nt; ++t) {
        const bf16_t* ur = u + (size_t)(it.r0 + t) * NU + ch;
        const float pc = bf2f(ur[1536]) * bf2f(ur[1792]);
        const float y = w0 * pm[0] + w1 * pm[1] + w2 * pc;
        mix[(size_t)(it.r0 + t) * D + 512 + ch] = f2bf(bf2f(ur[1280]) * y);
        if (wr_state && t >= it.L - 2) sdst[(t - (it.L - 2)) * 256] = pc;
        pm[0] = pm[1]; pm[1] = pc;
    }
}

__device__ __forceinline__ void cconv_item(const Params& p, int l, int ci, unsigned char* smem) {
    const int tid = opaque(threadIdx.x), lane = tid & 63, w = tid >> 6;
    const Item it = decode_item(ci);
    bf16_t* gl = (bf16_t*)smem;
    float* yb = (float*)(smem + 49152);
    const bf16_t* u = (const bf16_t*)(p.ws + WS_U);
    bf16_t* mix = (bf16_t*)(p.ws + WS_MIX);
    const int nrows = 30 + it.L;
#pragma unroll 1
    for (int idx = tid; idx < nrows * 32; idx += NTHR) {
        const int li = idx >> 5, part = idx & 31, tg = it.t0 - 30 + li;
        float gv[8];
        if (tg >= 0) {
            const bf16_t* ur = u + (size_t)(it.r0 - it.t0 + tg) * NU + part * 8;
            const u32x4 a = *(const u32x4*)(ur + 2048), g = *(const u32x4*)(ur + 2304);
#pragma unroll
            for (int e = 0; e < 4; ++e) { gv[2 * e] = bflo(a[e]) * sigmoidf_(bflo(g[e])); gv[2 * e + 1] = bfhi(a[e]) * sigmoidf_(bfhi(g[e])); }
        } else if (it.samp) {
            const float* sb = p.state_cconv + ((size_t)(l * NS + it.s) * 30 + li) * 256 + part * 8;
            const f32x4 a = *(const f32x4*)sb, b = *(const f32x4*)(sb + 4);
            gv[0] = a[0]; gv[1] = a[1]; gv[2] = a[2]; gv[3] = a[3]; gv[4] = b[0]; gv[5] = b[1]; gv[6] = b[2]; gv[7] = b[3];
        } else {
#pragma unroll
            for (int e = 0; e < 8; ++e) gv[e] = 0.f;
        }
        *(u32x4*)(gl + li * 256 + part * 8) = pack8(gv);
    }
    __syncthreads();
    if (it.samp || it.c == 63) {
        float* dst = it.samp ? p.out + O_CC_S + (size_t)(l * NS + it.s) * 7680 : p.out + O_CC_P + (size_t)(l * NB + it.b) * 7680;
        for (int idx = tid; idx < 7680; idx += NTHR) dst[idx] = bf2f(gl[it.L * 256 + idx]);
    }
    {
        const int ch = tid & 255, th = tid >> 8, nt = it.L / 2;
        float wk[31];
#pragma unroll
        for (int k = 0; k < 31; ++k) wk[k] = p.cconv_w[(l * 31 + k) * 256 + ch];
        const float bias = p.cconv_b[l * 256 + ch];
        for (int t = th * nt; t < th * nt + nt; ++t) {
            float a = bias;
#pragma unroll
            for (int k = 0; k < 31; ++k) a += wk[k] * bf2f(gl[(t + k) * 256 + ch]);
            yb[t * 256 + ch] = a;
        }
    }
    __syncthreads();
#pragma unroll 1
    for (int tt = 0; tt < 8; ++tt) {
        const int t = w * 8 + tt;
        if (t < it.L) {
            const f32x4 v = *(const f32x4*)(yb + t * 256 + lane * 4);
            const float mean = wave_sum(v[0] + v[1] + v[2] + v[3]) * (1.f / 256.f);
            const f32x4 d = v - mean;
            const float var = wave_sum(d[0] * d[0] + d[1] * d[1] + d[2] * d[2] + d[3] * d[3]) * (1.f / 256.f);
            const float rs = rsqrtf(var + EPS);
            const f32x4 gn = *(const f32x4*)(p.cconv_ln_g + l * 256 + lane * 4), bn = *(const f32x4*)(p.cconv_ln_b + l * 256 + lane * 4);
            float o[4];
#pragma unroll
            for (int e = 0; e < 4; ++e) o[e] = siluf_(d[e] * rs * gn[e] + bn[e]);
            u32x2 pk; pk[0] = pack_bf16(o[0], o[1]); pk[1] = pack_bf16(o[2], o[3]);
            *(u32x2*)(mix + (size_t)(it.r0 + t) * D + 768 + lane * 4) = pk;
        }
    }
    __syncthreads();
}

__device__ __forceinline__ void state_copies(const Params& p, int l) {
    const bf16_t* u = (const bf16_t*)(p.ws + WS_U);
    const int gt = blockIdx.x * NTHR + opaque(threadIdx.x), gs = gridDim.x * NTHR;
    for (int e = gt; e < 65536; e += gs) {
        const int b = e >> 14, i = (e >> 7) & 127, cd = e & 127;
        const bf16_t* src = u + (size_t)(b * SEQ + SEQ - 128 + i) * NU + cd;
        p.out[O_K_P + (size_t)l * 65536 + e] = bf2f(src[1024]); p.out[O_V_P + (size_t)l * 65536 + e] = bf2f(src[1152]);
        const int s = e >> 11, t = (e >> 7) & 15;
        const bf16_t* src2 = u + (size_t)(MP + s * LS + t) * NU + cd;
        p.out[O_K_S + (size_t)l * 65536 + e] = bf2f(src2[1024]); p.out[O_V_S + (size_t)l * 65536 + e] = bf2f(src2[1152]);
    }
    for (int e = gt; e < 6144; e += gs) {
        const int b = e / 1536, i = (e / 512) % 3, ch = e & 511;
        p.out[O_SCV_P + (size_t)l * 6144 + e] = bf2f(u[(size_t)(b * SEQ + SEQ - 3 + i) * NU + 256 + ch]);
    }
    for (int e = gt; e < 49152; e += gs) {
        const int s = e / 1536, i = (e / 512) % 3, ch = e & 511;
        p.out[O_SCV_S + (size_t)l * 49152 + e] = bf2f(u[(size_t)(MP + s * LS + LS - 3 + i) * NU + 256 + ch]);
    }
}

__global__ void __launch_bounds__(NTHR) mega(Params p0, int ph_lo, int ph_hi) {
    extern __shared__ __attribute__((aligned(16))) unsigned char smem[];
    for (int ph = ph_lo; ph < ph_hi; ++ph) {
        if (ph > ph_lo) cg::this_grid().sync();
        Params p = p0;
        asm volatile("" : "+s"(p.ws), "+s"(p.out));
        const int tid = opaque(threadIdx.x);
        if (ph == 0) {
            for (int it = blockIdx.x; it < 6018 + MT / 8; it += gridDim.x) {
                if (it < 6018) { if (EN(0)) prep_tile(p, it, smem); } else if (EN(1)) init_rows(p, it - 6018);
            }
        } else if (ph == NPH - 1) {
            const float* part = (const float*)(p.ws + WS_PART);
            const int lane = tid & 63, w = tid >> 6;
            for (int it = blockIdx.x; it < MT / 8; it += gridDim.x) {
                const int row = it * 8 + w; const float rs = rstd_row(part, row);
                float* X = p.out + (size_t)row * D;
#pragma unroll
                for (int i = 0; i < 4; ++i) {
                    const int c = i * 256 + lane * 4;
                    f32x4 v = *(const f32x4*)(X + c); const f32x4 g = *(const f32x4*)(p.norm_final + c);
                    v = v * rs * g; *(f32x4*)(X + c) = v;
                }
            }
        } else {
            const int l = (ph - 1) / 7, sp = (ph - 1) % 7;
            const bf16_t* xb = (const bf16_t*)(p.ws + WS_XB);
            float* part = (float*)(p.ws + WS_PART);
            if (sp == 0) {
                EpiU e{(bf16_t*)(p.ws + WS_U), part};
                if (EN(7)) gemm_phase(xb, (const bf16_t*)(p.ws + WS_WIN + l * W_IN_B), MT, NU, D, e, smem);
            } else if (sp == 1) {
                for (int it = blockIdx.x; it < 576 + 3 * NCI; it += gridDim.x) {
                    if (it < 576) { if (EN(2)) swa_item(p, l, it >> 1, it & 1, smem); }
                    else if (it < 576 + NCI) { if (EN(3)) ssd1_item(p, l, it - 576, smem); }
                    else if (it < 576 + 2 * NCI) { if (EN(4)) cconv_item(p, l, it - 576 - NCI, smem); }
                    else if (EN(5)) sconv_item(p, l, it - 576 - 2 * NCI);
                }
                state_copies(p, l);
            } else if (sp == 2) {
                float* S = (float*)(p.ws + WS_S); const float* dec = (const float*)(p.ws + WS_DEC);
                for (int e = blockIdx.x * NTHR + tid; e < 131072; e += gridDim.x * NTHR) {
                    const int b = e >> 15, rem = e & 32767, h = rem >> 13;
                    float hc = 0.f;
                    for (int c = 0; c < 64; ++c) {
                        const size_t o = (size_t)(b * 64 + c) * 32768 + rem;
                        const float s = S[o]; S[o] = hc; hc = dec[(b * 64 + c) * 4 + h] * hc + s;
                    }
                    p.out[O_SSM_P + (size_t)(l * NB + b) * 32768 + rem] = hc;
                }
            } else if (sp == 3) {
                for (int it = blockIdx.x; it < NCI; it += gridDim.x) if (EN(6)) ssd3_item(p, l, it, smem);
            } else if (sp == 4) {
                EpiRes e{p.out, (bf16_t*)(p.ws + WS_XB), part};
                if (EN(8)) gemm_phase((const bf16_t*)(p.ws + WS_MIX), (const bf16_t*)(p.ws + WS_WOUT + l * W_OUT_B), MT, D, D, e, smem);
            } else if (sp == 5) {
                EpiGlu e{(bf16_t*)(p.ws + WS_U), part};
                if (EN(9)) gemm_phase(xb, (const bf16_t*)(p.ws + WS_WGU + l * W_GU_B), MT, NGU, D, e, smem);
            } else {
                EpiRes e{p.out, (bf16_t*)(p.ws + WS_XB), part};
                if (EN(10)) gemm_phase((const bf16_t*)(p.ws + WS_U), (const bf16_t*)(p.ws + WS_WDN + l * W_DN_B), MT, D, DFF, e, smem);
            }
        }
    }
}

extern "C" void kernel_launch(void* const* d_in, const int* in_sizes, int n_in, void* d_out, int out_size, void* d_ws, size_t ws_size, hipStream_t stream) {
    static int grid = 0;
    if (grid == 0) {
        if (n_in != 28 || ws_size < WS_END || (size_t)out_size != O_END) { fprintf(stderr, "kernel_launch: unexpected shapes (n_in %d, out %d, ws %zu)\n", n_in, out_size, ws_size); grid = -1; return; }
        int dev = 0, cus = 0, per_cu = 0;
        hipGetDevice(&dev); hipDeviceGetAttribute(&cus, hipDeviceAttributeMultiprocessorCount, dev);
        if (hipFuncSetAttribute((const void*)mega, hipFuncAttributeMaxDynamicSharedMemorySize, LDS_BYTES) != hipSuccess) { fprintf(stderr, "hipFuncSetAttribute failed\n"); grid = -1; return; }
        if (hipOccupancyMaxActiveBlocksPerMultiprocessor(&per_cu, (const void*)mega, NTHR, LDS_BYTES) != hipSuccess || per_cu < 1) { fprintf(stderr, "occupancy query failed (%d)\n", per_cu); grid = -1; return; }
        grid = cus * 1;
    }
    if (grid < 0) return;
    Params p{};
    const float** pp = (const float**)&p;
    for (int i = 0; i < 28; ++i) pp[i] = (const float*)d_in[i];
    p.out = (float*)d_out; p.ws = (unsigned char*)d_ws;
#if MK_MULTI
    for (int ph = 0; ph < NPH; ++ph) hipLaunchKernelGGL(mega, dim3(grid), dim3(NTHR), LDS_BYTES, stream, p, ph, ph + 1);
#else
    int lo = 0, hi = NPH;
    void* args[] = {&p, &lo, &hi};
    hipError_t e = hipLaunchCooperativeKernel((const void*)mega, dim3(grid), dim3(NTHR), args, LDS_BYTES, stream);
    if (e != hipSuccess) fprintf(stderr, "cooperative launch failed: %s (grid %d)\n", hipGetErrorString(e), grid);
#endif
}
```

```cpp
#include <hip/hip_runtime.h>
#include <hip/hip_cooperative_groups.h>
#include <cstdio>
namespace cg = cooperative_groups;

#ifndef ONLY
#define ONLY -1
#endif
#define EN(k) (ONLY < 0 || ONLY == (k))
#ifndef RPT_SP
#define RPT_SP -1
#endif
#ifndef RPT_ITEM
#define RPT_ITEM -1
#endif
#define NR(k) ((RPT_ITEM == (k)) ? 2 : 1)
#ifndef RPT_N
#define RPT_N 1
#endif
#ifndef MK_MULTI
#define MK_MULTI 0
#endif

typedef unsigned short bf16_t;
typedef short bf16x8 __attribute__((ext_vector_type(8)));
typedef float f32x4 __attribute__((ext_vector_type(4)));
typedef unsigned u32x4 __attribute__((ext_vector_type(4)));
typedef unsigned u32x2 __attribute__((ext_vector_type(2)));

constexpr int D = 1024, NB = 4, SEQ = 4096, NS = 32, LS = 16, PAST = 1024;
constexpr int MP = NB * SEQ, MS = NS * LS, MT = MP + MS;
constexpr int NU = 2048, NW = 2560, DIN = 2564, DFF = 2816, NGU = 2 * DFF;
constexpr int NCI = 256 + NS;
constexpr float EPS = 1e-5f;
constexpr int NTHR = 512;
constexpr int LDS_BYTES = 128 * 1024;
constexpr int NPH = 16;
constexpr int LDS_TOTAL = LDS_BYTES + 64 + 16384;

constexpr size_t O_Y = 0;
constexpr size_t O_SSM_P = (size_t)MT * D;
constexpr size_t O_SSM_S = O_SSM_P + 2 * 4 * 4 * 64 * 128;
constexpr size_t O_SCV_P = O_SSM_S + 2 * 32 * 4 * 64 * 128;
constexpr size_t O_SCV_S = O_SCV_P + 2 * 4 * 3 * 512;
constexpr size_t O_K_P = O_SCV_S + 2 * 32 * 3 * 512;
constexpr size_t O_K_S = O_K_P + 2 * 4 * 128 * 128;
constexpr size_t O_V_P = O_K_S + 2 * 32 * 16 * 128;
constexpr size_t O_V_S = O_V_P + 2 * 4 * 128 * 128;
constexpr size_t O_SC_P = O_V_S + 2 * 32 * 16 * 128;
constexpr size_t O_SC_S = O_SC_P + 2 * 4 * 2 * 256;
constexpr size_t O_CC_P = O_SC_S + 2 * 32 * 2 * 256;
constexpr size_t O_CC_S = O_CC_P + 2 * 4 * 30 * 256;
constexpr size_t O_END = O_CC_S + 2 * 32 * 30 * 256;
static_assert(O_END == 20885504, "output size");

constexpr size_t W_IN_B = (size_t)NW * D * 2, W_OUT_B = (size_t)D * D * 2, W_GU_B = (size_t)NGU * D * 2, W_DN_B = (size_t)D * DFF * 2;
constexpr size_t WS_WIN = 0;
constexpr size_t WS_WOUT = WS_WIN + 2 * W_IN_B;
constexpr size_t WS_WGU = WS_WOUT + 2 * W_OUT_B;
constexpr size_t WS_WDN = WS_WGU + 2 * W_GU_B;
constexpr size_t WS_WDT = WS_WDN + 2 * W_DN_B;
constexpr size_t WS_XB = WS_WDT + 2 * 4 * 1024 * 4;
constexpr size_t WS_PART = WS_XB + (size_t)MT * D * 2;
constexpr size_t WS_DT = WS_PART + (size_t)MT * 16 * 4;
constexpr size_t WS_AC = WS_DT + (size_t)MT * 4 * 4;
constexpr size_t WS_DEC = WS_AC + (size_t)MT * 4 * 4;
constexpr size_t WS_U = WS_DEC + 4096;
constexpr size_t WS_XC = WS_U + (size_t)MT * NW * 2;
constexpr size_t WS_S = WS_XC + (size_t)MT * 512 * 2;
constexpr size_t WS_MIX = WS_S + (size_t)256 * 4 * 64 * 128 * 4;
constexpr size_t WS_BAR = WS_MIX + (size_t)MT * D * 2;
constexpr size_t WS_XCT = WS_BAR + 16384;
constexpr size_t WS_END = WS_XCT + (size_t)NCI * 16384 * 2;
static_assert(WS_END <= (size_t)256 * 1024 * 1024, "workspace too large");
static_assert((size_t)MT * DFF * 2 <= (WS_S - WS_U), "hb alias");

struct Params {
    const float* x_prompt; const float* x_sample; const float* state_ssm; const float* state_ssm_conv;
    const float* cache_k; const float* cache_v; const float* state_sconv; const float* state_cconv;
    const float* norm_mix; const float* w_in; const float* ssm_conv_w; const float* ssm_conv_b;
    const float* ssm_dt_bias; const float* ssm_a_log; const float* ssm_d; const float* ssm_norm;
    const float* sinks; const float* sconv_w; const float* cconv_w; const float* cconv_b;
    const float* cconv_ln_g; const float* cconv_ln_b; const float* w_out; const float* norm_ffn;
    const float* w_gate; const float* w_up; const float* w_down; const float* norm_final;
    float* out; unsigned char* ws;
};

__device__ __forceinline__ unsigned pack_bf16(float lo, float hi) { unsigned r; asm("v_cvt_pk_bf16_f32 %0, %1, %2" : "=v"(r) : "v"(lo), "v"(hi)); return r; }
__device__ __forceinline__ bf16_t f2bf(float f) { return (bf16_t)(pack_bf16(f, 0.f) & 0xffffu); }
__device__ __forceinline__ float bf2f(bf16_t h) { return __uint_as_float(((unsigned)h) << 16); }
__device__ __forceinline__ float bflo(unsigned u) { return __uint_as_float(u << 16); }
__device__ __forceinline__ float bfhi(unsigned u) { return __uint_as_float(u & 0xffff0000u); }
__device__ __forceinline__ f32x4 mfma16(bf16x8 a, bf16x8 b, f32x4 c) { return __builtin_amdgcn_mfma_f32_16x16x32_bf16(a, b, c, 0, 0, 0); }
__device__ __forceinline__ int opaque(int x) { asm volatile("" : "+v"(x)); return x; }
__device__ __forceinline__ float sigmoidf_(float x) { return __builtin_amdgcn_rcpf(1.f + __expf(-x)); }
__device__ __forceinline__ float siluf_(float x) { return x * sigmoidf_(x); }
__device__ __forceinline__ float wave_sum(float v) {
#pragma unroll
    for (int o = 32; o >= 1; o >>= 1) v += __shfl_xor(v, o);
    return v;
}
template <int N> __device__ __forceinline__ float wave_sum_multi(float (&v)[N], int lane) {
    int n = N;
#pragma unroll
    for (int o = 32; o >= 1; o >>= 1) {
        if (n > 1) {
            const bool hi = (lane & o) != 0; const int hn = n / 2;
#pragma unroll
            for (int i = 0; i < hn; ++i) { const float send = hi ? v[i] : v[i + hn], keep = hi ? v[i + hn] : v[i]; v[i] = keep + __shfl_xor(send, o); }
            n = hn;
        } else v[0] += __shfl_xor(v[0], o);
    }
    return v[0];
}
__device__ __forceinline__ float rstd_row(const float* part, int row) {
    const f32x4* pr = (const f32x4*)(part + (size_t)row * 16);
    const f32x4 a = pr[0] + pr[1] + pr[2] + pr[3];
    const float ss = (a[0] + a[1]) + (a[2] + a[3]);
    return rsqrtf(ss * (1.f / 1024.f) + EPS);
}
__device__ __forceinline__ float rstd_row_q(const float* part, int row, int fq) {
    const f32x4 a = *(const f32x4*)(part + (size_t)row * 16 + fq * 4);
    float ss = (a[0] + a[1]) + (a[2] + a[3]);
    ss += __shfl_xor(ss, 16); ss += __shfl_xor(ss, 32);
    return rsqrtf(ss * (1.f / 1024.f) + EPS);
}
__device__ __forceinline__ u32x4 pack8(const float* v) { u32x4 r; r[0] = pack_bf16(v[0], v[1]); r[1] = pack_bf16(v[2], v[3]); r[2] = pack_bf16(v[4], v[5]); r[3] = pack_bf16(v[6], v[7]); return r; }
__device__ __forceinline__ u32x4 load8f_bf(const float* src) { const f32x4 a = *(const f32x4*)src, b = *(const f32x4*)(src + 4); u32x4 r; r[0] = pack_bf16(a[0], a[1]); r[1] = pack_bf16(a[2], a[3]); r[2] = pack_bf16(b[0], b[1]); r[3] = pack_bf16(b[2], b[3]); return r; }

struct Item { int r0, L, t0, b, c, s; bool samp; };
__device__ __forceinline__ Item decode_item(int ci) {
    Item it;
    if (ci < 256) { it.samp = false; it.b = ci >> 6; it.c = ci & 63; it.s = 0; it.r0 = ci * 64; it.L = 64; it.t0 = it.c * 64; }
    else { it.samp = true; it.s = ci - 256; it.b = 0; it.c = 0; it.r0 = MP + it.s * LS; it.L = LS; it.t0 = 0; }
    return it;
}

#define XB_TMO      128
#define XB_XCNT(j)  (256  + 64 * (j))
#define XB_XSUB(j)  (1280 + 64 * (j))
#define XB_XGEN(j)  (2304 + 64 * (j))
#define XB_TOP      3328
#define XB_TOPGEN   3392
#define XCD_BAR_WORDS 3456
#define XB_SPIN_CAP (1u << 18)
#define LAS __attribute__((address_space(3)))

__device__ __forceinline__ unsigned xb_ld(unsigned* p)              { return __hip_atomic_load(p, __ATOMIC_RELAXED, __HIP_MEMORY_SCOPE_AGENT); }
__device__ __forceinline__ unsigned xb_add(unsigned* p, unsigned v) { return __hip_atomic_fetch_add(p, v, __ATOMIC_RELAXED, __HIP_MEMORY_SCOPE_AGENT); }
__device__ __forceinline__ unsigned xb_xcc_id() { return (unsigned)__builtin_amdgcn_s_getreg((3 << 11) | 20) & 0xFu; }
#define XB_SPIN(cond, bar) do { unsigned _sp = 0; while (cond) { __builtin_amdgcn_s_sleep(1); \
    if ((++_sp & 255u) == 0u) { if (xb_ld(&(bar)[XB_TMO])) break; if (_sp > XB_SPIN_CAP) { atomicAdd(&(bar)[XB_TMO], 1u); break; } } } } while (0)

struct XcdBarrier {
    unsigned* bar; unsigned x;
    volatile LAS unsigned* st;
};

__device__ __forceinline__ XcdBarrier xcd_barrier_post(unsigned* bar, volatile LAS unsigned* st) {
    XcdBarrier b; b.bar = bar; b.x = xb_xcc_id(); b.st = st;
    if (threadIdx.x == 0) (void)xb_add(&bar[XB_XCNT(b.x)], 1u);
    return b;
}
__device__ __forceinline__ void xcd_barrier_complete(unsigned* bar, unsigned x, unsigned& nloc, unsigned& nx) {
    const unsigned G = gridDim.x * gridDim.y * gridDim.z;
    unsigned sum, cnt, mine, sp = 0u;
    for (;;) {
        sum = 0u; cnt = 0u; mine = 0u;
#pragma unroll
        for (unsigned j = 0; j < 16; ++j) { const unsigned c = xb_ld(&bar[XB_XCNT(j)]); sum += c; cnt += (c > 0u) ? 1u : 0u; mine = (j == x) ? c : mine; }
        if (sum == G) break;
        __builtin_amdgcn_s_sleep(1);
        if ((++sp & 255u) == 0u) { if (xb_ld(&bar[XB_TMO])) break; if (sp > XB_SPIN_CAP) { atomicAdd(&bar[XB_TMO], 1u); break; } }
    }
    nloc = mine > 0u ? mine : 1u; nx = cnt > 0u ? cnt : 1u;
}

__device__ __forceinline__ void xcd_barrier(const XcdBarrier& b) {
    asm volatile("s_waitcnt vmcnt(0)" ::: "memory");
    __syncthreads();
    if (threadIdx.x == 0) {
        unsigned* bar = b.bar;
        __builtin_amdgcn_s_waitcnt(0);
        unsigned nloc = b.st[0], nx = b.st[1];
        if (nloc == 0u) { xcd_barrier_complete(bar, b.x, nloc, nx); b.st[0] = nloc; b.st[1] = nx; }
        const unsigned old = xb_add(&bar[XB_XSUB(b.x)], 1u);
        const unsigned gen = old / nloc;
        if (old + 1u == (gen + 1u) * nloc) {
            __builtin_amdgcn_fence(__ATOMIC_RELEASE, "agent");
            asm volatile("s_waitcnt vmcnt(0)" ::: "memory");
            const unsigned og = xb_add(&bar[XB_TOP], 1u);
            const unsigned tg = og / nx;
            if (og + 1u == (tg + 1u) * nx) xb_add(&bar[XB_TOPGEN], 1u);
            else XB_SPIN(xb_ld(&bar[XB_TOPGEN]) == tg, bar);
            __builtin_amdgcn_fence(__ATOMIC_ACQUIRE, "agent");
            xb_add(&bar[XB_XGEN(b.x)], 1u);
            asm volatile("s_waitcnt vmcnt(0)" ::: "memory");
        } else {
            XB_SPIN(xb_ld(&bar[XB_XGEN(b.x)]) == gen, bar);
            __builtin_amdgcn_fence(__ATOMIC_ACQUIRE, "agent");
            asm volatile("s_waitcnt vmcnt(0)" ::: "memory");
        }
    }
    __syncthreads();
}

namespace pg8 {
#define PG8_LAS __attribute__((address_space(3)))
typedef unsigned short bf16_t;
typedef short bf16x8 __attribute__((ext_vector_type(8)));
typedef float f32x4 __attribute__((ext_vector_type(4)));
typedef unsigned u32x4 __attribute__((ext_vector_type(4)));
constexpr int BM = 256, BK = 64, HALF = 128, HTB = HALF * BK * 2  , STAGE_BYTES = 8 * HTB, NXCD = 8, WGM = 4;

__host__ __device__ __forceinline__ int lds_byte(int r, int c) { const int st = (r >> 4) * 2 + (c >> 5), rr = r & 15, cc = c & 31, ob = rr * 64 + cc * 2; return st * 1024 + (ob ^ (((ob >> 9) & 1) << 5)); }
__host__ __device__ __forceinline__ void stage_rc(int b, int& R, int& C) { const int st = b / 1024, sb = b % 1024, swz = sb ^ (((sb >> 9) & 1) << 5); R = (st >> 1) * 16 + swz / 64; C = (st & 1) * 32 + (swz % 64) / 2; }
__host__ __device__ __forceinline__ int perm32(int rho) { const int n = rho >> 4, i = rho & 15; return 8 * (i >> 2) + 4 * n + (i & 3); }

struct Unit { int pm, pn; };
struct Gemm { const bf16_t* A; const bf16_t* Bt; int M, N, K; };

struct StaticOrder {
    int nM, nN, nwg, G, c;
    __host__ __device__ void init(int M, int N, int G_, int c_) { nM = M / BM; nN = N / BM; nwg = nM * nN; G = G_; c = c_; }
    __host__ __device__ bool next(int i, Unit& u) const {
        const long L = (long)i * G + c; if (L >= nwg) return false;
        int wgid = (int)L; { const int q = nwg / NXCD, r = nwg % NXCD, xcd = wgid % NXCD, off = wgid / NXCD; wgid = (xcd < r ? xcd * (q + 1) : r * (q + 1) + (xcd - r) * q) + off; }
        const int nig = WGM * nN, gid = wgid / nig, fm = gid * WGM, gsz = (nM - fm) < WGM ? (nM - fm) : WGM;
        u.pm = fm + ((wgid % nig) % gsz); u.pn = (wgid % nig) / gsz; return true;
    }
    __device__ __forceinline__ void a_ready(const Unit&) const {}
    __device__ __forceinline__ void done(const Unit&) const {}
};
template <class Epi, class Sched, bool STAMP = false, class Pre>
__device__ __forceinline__ void gemm_phase(PG8_LAS unsigned char* lds, const Gemm g, const Sched& S, const Epi& E, unsigned long long* stamps, const Pre& pre) {
    const int tid = opaque(threadIdx.x), wid = __builtin_amdgcn_readfirstlane(tid >> 6), lane = tid & 63, wr = wid >> 2, wc = wid & 3, fr = lane & 15, fq = lane >> 4;
    const int K = g.K, nt = K / BK;
    int ts_lo = 0, ts_hi = 0, nts = 0; const unsigned long long rt_entry = STAMP ? (unsigned long long)wall_clock64() : 0ull;
#define PG8_STAMP() do { if (STAMP && wid == 0 && nts < 64) { const unsigned long long _c = (unsigned long long)clock64(); \
        ts_lo = (lane == nts) ? (int)(unsigned)_c : ts_lo; ts_hi = (lane == nts) ? (int)(unsigned)(_c >> 32) : ts_hi; ++nts; } } while (0)
    PG8_STAMP();
    unsigned voffA[2], voffB[2];
#pragma unroll
    for (int i = 0; i < 2; ++i) { int R, C; stage_rc(tid * 16 + i * 8192, R, C); const int Rb = Epi::PERM ? ((R & ~31) + perm32(R & 31)) : R;
        voffA[i] = (unsigned)(R * K + C) * 2u; voffB[i] = (unsigned)(Rb * K + C) * 2u; }
    const size_t kstep = (size_t)(BK * 2);
    const size_t hstep = (size_t)HALF * K * 2;
    const size_t tstep = 2 * hstep;
    const unsigned ldsw = (unsigned)wid * 1024u;
    const int aoff = lds_byte(wr * 64 + fr, fq * 8), boff = lds_byte(wc * 32 + fr, fq * 8);
#define PG8_SA(b, h) (((b) * 2 + (h)) * HTB)
#define PG8_SB(b, h) ((4 + (b) * 2 + (h)) * HTB)
#define PG8_STAGE(bufoff, gbase, voff) do { _Pragma("unroll") for (int _i = 0; _i < 2; ++_i) \
        __builtin_amdgcn_global_load_lds((const unsigned*)((const char*)(gbase) + (voff)[_i]), (PG8_LAS unsigned*)(lds + (bufoff) + ldsw + _i * 8192), 16, 0, 0); } while (0)
#define PG8_LDA(dst, b, h) do { _Pragma("unroll") for (int m = 0; m < 4; ++m) _Pragma("unroll") for (int k = 0; k < 2; ++k) dst[m][k] = *(const PG8_LAS bf16x8*)(lds + PG8_SA(b, h) + aoff + m * 2048 + k * 1024); } while (0)
#define PG8_LDB(dst, b, h) do { _Pragma("unroll") for (int n = 0; n < 2; ++n) _Pragma("unroll") for (int k = 0; k < 2; ++k) dst[n][k] = *(const PG8_LAS bf16x8*)(lds + PG8_SB(b, h) + boff + n * 2048 + k * 1024); } while (0)
#define PG8_MMA(ai, bj, At, Bt) do { __builtin_amdgcn_s_setprio(1); _Pragma("unroll") for (int m = 0; m < 4; ++m) _Pragma("unroll") for (int n = 0; n < 2; ++n) _Pragma("unroll") for (int k = 0; k < 2; ++k) \
        acc[ai][bj][m][n] = __builtin_amdgcn_mfma_f32_16x16x32_bf16(Bt[n][k], At[m][k], acc[ai][bj][m][n], 0, 0, 0); __builtin_amdgcn_s_setprio(0); } while (0)
#define PG8_WAIT_V(n) asm volatile("s_waitcnt vmcnt(" #n ")" ::: "memory")
#define PG8_WAIT_L(n) asm volatile("s_waitcnt lgkmcnt(" #n ")" ::: "memory")
#define PG8_BAR __builtin_amdgcn_s_barrier()
#define PG8_SCHED __builtin_amdgcn_sched_barrier(0)
    Unit cur, nxt; int ui = 0;
    if (!S.next(0, cur)) return;
    f32x4 acc[2][2][4][2];
#pragma unroll
    for (int a = 0; a < 2; ++a)
#pragma unroll
        for (int b = 0; b < 2; ++b)
#pragma unroll
            for (int m = 0; m < 4; ++m)
#pragma unroll
                for (int n = 0; n < 2; ++n) acc[a][b][m][n] = (f32x4){0.f, 0.f, 0.f, 0.f};
    bf16x8 At[4][2], B0[2][2], B1[2][2];
    const char* cA = (const char*)g.A + (size_t)cur.pm * tstep; const char* cB = (const char*)g.Bt + (size_t)cur.pn * tstep;
    S.a_ready(cur);
    PG8_STAGE(PG8_SB(0, 0), cB, voffB); PG8_STAGE(PG8_SA(0, 0), cA, voffA); PG8_STAGE(PG8_SB(0, 1), cB + hstep, voffB); PG8_STAGE(PG8_SA(0, 1), cA + hstep, voffA);
    pre();
    if (wr == 1) PG8_BAR;
    PG8_WAIT_V(4); PG8_BAR;
    PG8_STAGE(PG8_SB(1, 0), cB + kstep, voffB); PG8_STAGE(PG8_SA(1, 0), cA + kstep, voffA); PG8_STAGE(PG8_SB(1, 1), cB + hstep + kstep, voffB);
    PG8_WAIT_V(6); PG8_BAR;
    PG8_STAMP();
    for (;;) {
        const bool has_next = S.next(ui + 1, nxt);
        const char* nA = has_next ? (const char*)g.A + (size_t)nxt.pm * tstep : cA; const char* nB = has_next ? (const char*)g.Bt + (size_t)nxt.pn * tstep : cB;
        for (int t = 0; t < nt; t += 2) {
            const bool last = (t == nt - 2);
            const char* a1 = cA + (size_t)(t + 1) * kstep;
            const char* a2 = last ? nA : cA + (size_t)(t + 2) * kstep; const char* b2 = last ? nB : cB + (size_t)(t + 2) * kstep;
            const char* a3 = a2 + kstep; const char* b3 = b2 + kstep;
            if (last && has_next) S.a_ready(nxt);
            PG8_LDB(B0, 0, 0); PG8_SCHED; PG8_LDA(At, 0, 0); PG8_STAGE(PG8_SA(1, 1), a1 + hstep, voffA);
            PG8_WAIT_L(8); PG8_BAR; PG8_WAIT_L(0); PG8_MMA(0, 0, At, B0); PG8_BAR; PG8_SCHED;
            PG8_LDB(B1, 0, 1); PG8_STAGE(PG8_SB(0, 0), b2, voffB);
            PG8_BAR; PG8_WAIT_L(0); PG8_MMA(0, 1, At, B1); PG8_BAR;
            PG8_LDA(At, 0, 1); PG8_STAGE(PG8_SA(0, 0), a2, voffA);
            PG8_BAR; PG8_WAIT_L(0); PG8_MMA(1, 0, At, B0); PG8_BAR; PG8_SCHED;
            PG8_STAGE(PG8_SB(0, 1), b2 + hstep, voffB);
            PG8_WAIT_V(6); PG8_BAR; PG8_MMA(1, 1, At, B1); PG8_BAR;
            PG8_LDB(B0, 1, 0); PG8_SCHED; PG8_LDA(At, 1, 0); PG8_STAGE(PG8_SA(0, 1), a2 + hstep, voffA);
            PG8_WAIT_L(8); PG8_BAR; PG8_WAIT_L(0); PG8_MMA(0, 0, At, B0); PG8_BAR; PG8_SCHED;
            PG8_LDB(B1, 1, 1); PG8_STAGE(PG8_SB(1, 0), b3, voffB);
            PG8_BAR; PG8_WAIT_L(0); PG8_MMA(0, 1, At, B1); PG8_BAR;
            PG8_LDA(At, 1, 1); PG8_STAGE(PG8_SA(1, 0), a3, voffA);
            PG8_BAR; PG8_WAIT_L(0); PG8_MMA(1, 0, At, B0); PG8_BAR; PG8_SCHED;
            PG8_STAGE(PG8_SB(1, 1), b3 + hstep, voffB);
            PG8_WAIT_V(6); PG8_BAR; PG8_MMA(1, 1, At, B1); PG8_BAR;
        }
        PG8_STAMP();
        if constexpr (!Epi::AFTER_DRAIN) { E(acc, cur, ui, wr, wc, fr, fq); S.done(cur); }
        PG8_STAMP();
        if (!has_next) break;
#pragma unroll
        for (int a = 0; a < 2; ++a)
#pragma unroll
            for (int b = 0; b < 2; ++b)
#pragma unroll
                for (int m = 0; m < 4; ++m)
#pragma unroll
                    for (int n = 0; n < 2; ++n) acc[a][b][m][n] = (f32x4){0.f, 0.f, 0.f, 0.f};
        cur = nxt; cA = nA; cB = nB; ++ui;
    }
    PG8_WAIT_V(0);
    if (wr == 0) PG8_BAR;
    PG8_BAR;
    if constexpr (Epi::AFTER_DRAIN) { E.fused(acc, cur, wr, wc, fr, fq, lds, wid, lane); S.done(cur); }
    PG8_STAMP();
    if (STAMP && wid == 0) { stamps[lane] = lane < nts ? (((unsigned long long)(unsigned)ts_hi << 32) | (unsigned)ts_lo) : 0ull;
        if (lane == 62) stamps[62] = rt_entry; if (lane == 63) stamps[63] = (unsigned long long)wall_clock64(); }
#undef PG8_STAMP
#undef PG8_SA
#undef PG8_SB
#undef PG8_STAGE
#undef PG8_LDA
#undef PG8_LDB
#undef PG8_MMA
#undef PG8_WAIT_V
#undef PG8_WAIT_L
#undef PG8_BAR
#undef PG8_SCHED
}
}

struct EpiU {
    static constexpr bool PERM = true, AFTER_DRAIN = false;
    bf16_t* u; const float* rtab;
    __device__ __forceinline__ void operator()(const f32x4 (&acc)[2][2][4][2], const pg8::Unit& un, int ui, int wr, int wc, int fr, int fq) const {
        if (un.pn < 6) {
#pragma unroll
            for (int ai = 0; ai < 2; ++ai)
#pragma unroll
                for (int m = 0; m < 4; ++m) {
                    const int row = un.pm * 256 + ai * 128 + wr * 64 + m * 16 + fr; const float rs = rtab[ui * 256 + ai * 128 + wr * 64 + m * 16 + fr];
                    bf16_t* dst = u + (size_t)row * NU + un.pn * 256 + wc * 32 + fq * 8;
#pragma unroll
                    for (int bj = 0; bj < 2; ++bj) {
                        const f32x4 a = acc[ai][bj][m][0], b = acc[ai][bj][m][1]; u32x4 v;
                        v[0] = pack_bf16(a[0] * rs, a[1] * rs); v[1] = pack_bf16(a[2] * rs, a[3] * rs); v[2] = pack_bf16(b[0] * rs, b[1] * rs); v[3] = pack_bf16(b[2] * rs, b[3] * rs);
                        *(u32x4*)(dst + bj * 128) = v;
                    }
                }
        } else {
            const int t = un.pn - 6; const bool glu = t >= 2;
            const int cbase = (glu ? 1792 + 128 * (t - 2) : 1536 + 128 * t) + wc * 32 + fq * 8;
#pragma unroll
            for (int ai = 0; ai < 2; ++ai)
#pragma unroll
                for (int m = 0; m < 4; ++m) {
                    const int row = un.pm * 256 + ai * 128 + wr * 64 + m * 16 + fr; const float rs = rtab[ui * 256 + ai * 128 + wr * 64 + m * 16 + fr];
                    float x8[8], y8[8];
#pragma unroll
                    for (int q = 0; q < 8; ++q) { x8[q] = acc[ai][q >> 2][m][0][q & 3] * rs; y8[q] = acc[ai][q >> 2][m][1][q & 3] * rs; }
                    if (glu) {
#pragma unroll
                        for (int q = 0; q < 8; ++q) y8[q] = __builtin_amdgcn_exp2f(y8[q] * -1.4426950408889634f);
#pragma unroll
                        for (int q = 0; q < 8; ++q) y8[q] = __builtin_amdgcn_rcpf(1.f + y8[q]);
                    }
#pragma unroll
                    for (int q = 0; q < 8; ++q) x8[q] *= y8[q];
                    *(u32x4*)(u + (size_t)row * NU + cbase) = pack8(x8);
                }
        }
    }
};
struct EpiRes {
    static constexpr bool PERM = true, AFTER_DRAIN = false;
    bf16_t* xb; float* part;
    __device__ __forceinline__ void operator()(const f32x4 (&acc)[2][2][4][2], const pg8::Unit& un, int ui, int wr, int wc, int fr, int fq) const {
        bf16_t* x0 = xb + (size_t)(un.pm * 256 + wr * 64 + fr) * D + un.pn * 256 + wc * 32 + fq * 8;
        u32x4 old[2][4][2];
#pragma unroll
        for (int ai = 0; ai < 2; ++ai)
#pragma unroll
            for (int m = 0; m < 4; ++m)
#pragma unroll
                for (int bj = 0; bj < 2; ++bj) old[ai][m][bj] = *(const u32x4*)(x0 + (size_t)(ai * 128 + m * 16) * D + bj * 128);
#pragma unroll
        for (int ai = 0; ai < 2; ++ai)
#pragma unroll
            for (int m = 0; m < 4; ++m) {
                const int row = un.pm * 256 + ai * 128 + wr * 64 + m * 16 + fr; float ss = 0.f;
                bf16_t* xr = x0 + (size_t)(ai * 128 + m * 16) * D;
#pragma unroll
                for (int bj = 0; bj < 2; ++bj) {
                    float v[8];
#pragma unroll
                    for (int q = 0; q < 4; ++q) { v[2 * q] = bflo(old[ai][m][bj][q]) + acc[ai][bj][m][q >> 1][(2 * q) & 3]; v[2 * q + 1] = bfhi(old[ai][m][bj][q]) + acc[ai][bj][m][q >> 1][(2 * q + 1) & 3]; }
#pragma unroll
                    for (int q = 0; q < 8; ++q) ss += v[q] * v[q];
                    *(u32x4*)(xr + bj * 128) = pack8(v);
                }
                ss += __shfl_xor(ss, 16); ss += __shfl_xor(ss, 32);
                if (fq == 0) part[(size_t)row * 16 + un.pn * 4 + wc] = ss;
            }
    }
};
struct EpiGlu {
    static constexpr bool PERM = false, AFTER_DRAIN = false;
    bf16_t* hb; const float* rtab;
    __device__ __forceinline__ void operator()(const f32x4 (&acc)[2][2][4][2], const pg8::Unit& un, int ui, int wr, int wc, int fr, int fq) const {
#pragma unroll
        for (int ai = 0; ai < 2; ++ai)
#pragma unroll
            for (int m = 0; m < 4; ++m) {
                const int row = un.pm * 256 + ai * 128 + wr * 64 + m * 16 + fr; const float rs = rtab[ui * 256 + ai * 128 + wr * 64 + m * 16 + fr];
                const float nrs = rs * -1.4426950408889634f, rs2 = rs * rs;
                typedef float f32x2_ __attribute__((ext_vector_type(2)));
                float h[8]; f32x2_ t2[4], h2[4];
#pragma unroll
                for (int q = 0; q < 4; ++q) {
                    const f32x2_ g2 = {acc[ai][q >> 1][m][0][(2 * q) & 3], acc[ai][q >> 1][m][0][(2 * q + 1) & 3]}, u2 = {acc[ai][q >> 1][m][1][(2 * q) & 3], acc[ai][q >> 1][m][1][(2 * q + 1) & 3]};
                    const f32x2_ a2 = g2 * nrs; t2[q][0] = __builtin_amdgcn_exp2f(a2[0]); t2[q][1] = __builtin_amdgcn_exp2f(a2[1]);
                    h2[q] = (g2 * u2) * rs2;
                }
#pragma unroll
                for (int q = 0; q < 4; ++q) { const f32x2_ d2 = t2[q] + 1.f; t2[q][0] = __builtin_amdgcn_rcpf(d2[0]); t2[q][1] = __builtin_amdgcn_rcpf(d2[1]); }
#pragma unroll
                for (int q = 0; q < 4; ++q) { const f32x2_ r2 = h2[q] * t2[q]; h[2 * q] = r2[0]; h[2 * q + 1] = r2[1]; }
                *(u32x4*)(hb + (size_t)row * DFF + un.pn * 128 + wc * 32 + fq * 8) = pack8(h);
            }
    }
};
struct PreNone { __device__ __forceinline__ void operator()() const {} };
struct PreRstd {
    const float* part; int M, N; float* rtab;
    __device__ __forceinline__ void operator()() const {
        const int tid = opaque(threadIdx.x);
        pg8::StaticOrder S; S.init(M, N, (int)gridDim.x, (int)blockIdx.x);
        pg8::Unit un;
        for (int i = 0; i < 16 && S.next(i, un); ++i) if (tid < 256) rtab[i * 256 + tid] = rstd_row(part, un.pm * 256 + tid);
    }
};
__device__ __forceinline__ float* rstd_table_ptr(unsigned char* smem) { return (float*)(smem + LDS_BYTES + 64); }
template <class Epi, class Pre>
__device__ __forceinline__ void run_gemm(const bf16_t* A, const bf16_t* Bt, int M, int N, int K, const Epi& e, unsigned char* smem, const Pre& pre) {
    pg8::Gemm g{A, Bt, M, N, K};
    pg8::StaticOrder S; S.init(M, N, (int)gridDim.x, (int)blockIdx.x);
    pg8::gemm_phase<Epi, pg8::StaticOrder, false, Pre>((PG8_LAS unsigned char*)smem, g, S, e, nullptr, pre);
}

__device__ __forceinline__ void gemm_small_res(const bf16_t* A, const bf16_t* Bt, int K, bf16_t* xb, float* part, unsigned char* smem) {
    const int tid = opaque(threadIdx.x), lane = tid & 63, w = tid >> 6, fr = lane & 15, fq = lane >> 4;
    float* red = (float*)smem;
    float* ssb = (float*)(smem + 65536);
    const int kw = K / 8;
    for (int tile = blockIdx.x; tile < 256; tile += gridDim.x) {
        const int row0 = MP + (tile >> 4) * 32, col0 = (tile & 15) * 64;
        f32x4 acc[2][4];
#pragma unroll
        for (int i = 0; i < 2; ++i)
#pragma unroll
            for (int j = 0; j < 4; ++j) acc[i][j] = (f32x4){0.f, 0.f, 0.f, 0.f};
        const bf16_t* ap = A + (size_t)(row0 + fr) * K + w * kw + fq * 8;
        const bf16_t* bp = Bt + (size_t)(col0 + fr) * K + w * kw + fq * 8;
        const int mt = w >> 2, nt = w & 3, rl = mt * 16 + fr;
        const size_t o = (size_t)(row0 + rl) * D + col0 + nt * 16 + fq * 4;
        const u32x2 ob = *(const u32x2*)(xb + o);
#pragma unroll 6
        for (int k = 0; k < kw; k += 32) {
            bf16x8 af[2], bfv[4];
#pragma unroll
            for (int i = 0; i < 2; ++i) af[i] = *(const bf16x8*)(ap + (size_t)i * 16 * K + k);
#pragma unroll
            for (int j = 0; j < 4; ++j) bfv[j] = *(const bf16x8*)(bp + (size_t)j * 16 * K + k);
#pragma unroll
            for (int i = 0; i < 2; ++i)
#pragma unroll
                for (int j = 0; j < 4; ++j) acc[i][j] = mfma16(bfv[j], af[i], acc[i][j]);
        }
        __syncthreads();
#pragma unroll
        for (int i = 0; i < 2; ++i)
#pragma unroll
            for (int j = 0; j < 4; ++j) *(f32x4*)(red + (size_t)(((w * 8 + i * 4 + j) * 64 + lane) * 4)) = acc[i][j];
        __syncthreads();
        f32x4 sum = (f32x4){0.f, 0.f, 0.f, 0.f};
#pragma unroll
        for (int ww = 0; ww < 8; ++ww) sum += *(const f32x4*)(red + (size_t)(((ww * 8 + w) * 64 + lane) * 4));
        f32x4 v; v[0] = bflo(ob[0]) + sum[0]; v[1] = bfhi(ob[0]) + sum[1]; v[2] = bflo(ob[1]) + sum[2]; v[3] = bfhi(ob[1]) + sum[3];
        u32x2 pk; pk[0] = pack_bf16(v[0], v[1]); pk[1] = pack_bf16(v[2], v[3]); *(u32x2*)(xb + o) = pk;
        ssb[rl * 16 + nt * 4 + fq] = v[0] * v[0] + v[1] * v[1] + v[2] * v[2] + v[3] * v[3];
        __syncthreads();
        if (tid < 32) {
            const f32x4* sp = (const f32x4*)(ssb + tid * 16); const f32x4 a = sp[0] + sp[1] + sp[2] + sp[3];
            part[(size_t)(row0 + tid) * 16 + (tile & 15)] = (a[0] + a[1]) + (a[2] + a[3]);
        }
    }
    __syncthreads();
}

struct PrepT { int l, kind, n0, k0, K; };
__device__ __forceinline__ PrepT prep_decode(int it) {
    PrepT t; t.l = it / 753; int r = it % 753;
    if (r == 752) { t.kind = 4; t.n0 = 0; t.k0 = 0; t.K = 0; return t; }
    int tn, tk;
    if (r < 160) { t.kind = 0; tn = r >> 2; tk = r & 3; t.K = 1024; }
    else if (r < 224) { r -= 160; t.kind = 1; tn = r >> 2; tk = r & 3; t.K = 1024; }
    else if (r < 576) { r -= 224; t.kind = 2; tn = r >> 2; tk = r & 3; t.K = 1024; }
    else { r -= 576; t.kind = 3; tn = r / 11; tk = r % 11; t.K = DFF; }
    t.n0 = tn * 64; t.k0 = tk * 256; return t;
}
struct V8 { f32x4 a[8]; };
__device__ __forceinline__ V8 prep_load(const Params& p, const PrepT& t, int tid) {
    V8 r;
#pragma unroll
    for (int i = 0; i < 8; ++i) r.a[i] = (f32x4){0.f, 0.f, 0.f, 0.f};
    if (t.kind == 4) return r;
    const int l = t.l, nn = (tid & 15) * 4, n = t.n0 + nn, kb = tid >> 4;
    const float* src; size_t ld;
    if (t.kind == 0) {
        int col;
        if (n < 1536) col = n < 768 ? n : n + 4;
        else {
            const int tt = (n - 1536) >> 8, c = n & 255, o = ((c >> 5) & 3) * 32 + ((c >> 3) & 3) * 8 + ((c >> 7) & 1) * 4, second = (c >> 2) & 1;
            col = (tt < 2 ? (second ? 1792 : 1536) + 128 * tt : (second ? 2304 : 2048) + 128 * (tt - 2)) + o + 4;
        }
        src = p.w_in + (size_t)l * D * DIN + col; ld = DIN;
    }
    else if (t.kind == 1) { src = p.w_out + (size_t)l * D * D + n; ld = D; }
    else if (t.kind == 2) { src = (((n >> 4) & 1) ? p.w_up : p.w_gate) + (size_t)l * D * DFF + (n >> 8) * 128 + ((n >> 5) & 3) * 32 + ((n >> 2) & 3) * 8 + ((n >> 7) & 1) * 4; ld = DFF; }
    else { src = p.w_down + (size_t)l * DFF * D + n; ld = D; }
#pragma unroll
    for (int i = 0; i < 8; ++i) r.a[i] = *(const f32x4*)(src + (size_t)(t.k0 + kb + 32 * i) * ld);
    return r;
}
__device__ __forceinline__ void prep_finish(const Params& p, const PrepT& t, int tid, const V8 vv, unsigned char* smem) {
    const int l = t.l;
    if (t.kind == 4) {
        float* wdt = (float*)(p.ws + WS_WDT) + (size_t)l * 4096;
        for (int e = tid; e < 4096; e += NTHR) { const int h = e >> 10, k = e & 1023; wdt[e] = p.norm_mix[l * D + k] * p.w_in[((size_t)l * D + k) * DIN + 768 + h]; }
        return;
    }
    float* tile = (float*)smem;
    __syncthreads();
    {
        const int nn = (tid & 15) * 4, kb = tid >> 4;
        const float* gain = t.kind == 0 ? p.norm_mix + l * D : (t.kind == 2 ? p.norm_ffn + l * D : nullptr);
#pragma unroll
        for (int i = 0; i < 8; ++i) {
            const int kk = kb + 32 * i; const float gsc = gain ? gain[t.k0 + kk] : 1.f;
#pragma unroll
            for (int e = 0; e < 4; ++e) tile[(nn + e) * 257 + kk] = vv.a[i][e] * gsc;
        }
    }
    __syncthreads();
    bf16_t* dst = (bf16_t*)(p.ws + (t.kind == 0 ? WS_WIN + l * W_IN_B : t.kind == 1 ? WS_WOUT + l * W_OUT_B : t.kind == 2 ? WS_WGU + l * W_GU_B : WS_WDN + l * W_DN_B));
#pragma unroll 4
    for (int i = 0; i < 16; ++i) {
        const int idx = tid + NTHR * i, nn = idx >> 7, kp = idx & 127;
        *(unsigned*)(dst + (size_t)(t.n0 + nn) * t.K + t.k0 + 2 * kp) = pack_bf16(tile[nn * 257 + 2 * kp], tile[nn * 257 + 2 * kp + 1]);
    }
}
struct Row4 { f32x4 a[4]; };
__device__ __forceinline__ Row4 init_rows_load(const Params& p, int it, int tid) {
    const int lane = tid & 63, w = tid >> 6, row = it * 8 + w;
    const float* src = row < MP ? p.x_prompt + (size_t)row * D : p.x_sample + (size_t)(row - MP) * D;
    Row4 r;
#pragma unroll
    for (int i = 0; i < 4; ++i) r.a[i] = *(const f32x4*)(src + i * 256 + lane * 4);
    return r;
}
__device__ __forceinline__ void init_rows_finish(const Params& p, int it, int tid, const Row4 r) {
    const int lane = tid & 63, w = tid >> 6, row = it * 8 + w;
    bf16_t* xb = (bf16_t*)(p.ws + WS_XB) + (size_t)row * D;
    float ss = 0.f;
#pragma unroll
    for (int i = 0; i < 4; ++i) {
        const int c = i * 256 + lane * 4; const f32x4 v = r.a[i];
        u32x2 pk; pk[0] = pack_bf16(v[0], v[1]); pk[1] = pack_bf16(v[2], v[3]); *(u32x2*)(xb + c) = pk;
        ss += v[0] * v[0] + v[1] * v[1] + v[2] * v[2] + v[3] * v[3];
    }
    ss = wave_sum(ss);
    if (lane < 16) ((float*)(p.ws + WS_PART))[(size_t)row * 16 + lane] = lane == 0 ? ss : 0.f;
}
__device__ __forceinline__ void prep_in_idle_slots(const Params& p, int nwg, int a_lo, int a_hi, int b_lo, int b_hi, int c_item, unsigned char* smem) {
    const int tid = opaque(threadIdx.x);
    const int G = (int)gridDim.x, rounds = (nwg + G - 1) / G;
    int first_idle = nwg - (rounds - 1) * G, nidle = G - first_idle;
    if (nidle <= 0) { first_idle = 0; nidle = G; }
    const int j = (int)blockIdx.x - first_idle;
    if (j < 0) return;
    const int na = a_hi - a_lo, nb = b_hi - b_lo, ntot = na + nb + (c_item >= 0 ? 1 : 0);
    for (int v = j; v < ntot; v += nidle) {
        const int it = v < na ? a_lo + v : (v < na + nb ? b_lo + (v - na) : c_item);
        const PrepT t = prep_decode(it);
        const V8 vv = prep_load(p, t, tid);
        prep_finish(p, t, tid, vv, smem);
    }
    __syncthreads();
}

__device__ __forceinline__ void swa_item(const Params& p, int l, int ci, int kvh, unsigned char* smem) {
    const int tid = opaque(threadIdx.x), lane = tid & 63, w = tid >> 6, fr = lane & 15, fq = lane >> 4;
    const Item it = decode_item(ci);
    bf16_t* Ks = (bf16_t*)smem;
    bf16_t* Vt = (bf16_t*)(smem + 27648);
    bf16_t* Ps = (bf16_t*)(smem + 27648 + 25600);
    float* invs = (float*)(smem + 27648 + 25600 + 51200);
    const bf16_t* u = (const bf16_t*)(p.ws + WS_U);
    bf16_t* mix = (bf16_t*)(p.ws + WS_MIX);
    const int kbase = it.samp ? (PAST - 128) : (it.t0 - 128);
    const int qbase = it.samp ? PAST : it.t0;
    const int nkeys = it.samp ? 144 : 192;
    bf16_t* Vr = Ps;
    const float sink = p.sinks[l * 4 + kvh * 2 + (tid >> 8)];
    bf16x8 qf[2];
    {
        const int qt_ = (tid >> 6) & 3, h_ = kvh * 2 + (tid >> 8);
        const int qrow = it.r0 + ((qt_ * 16 < it.L) ? qt_ * 16 + fr : fr);
        const bf16_t* qsrc = u + (size_t)qrow * NU + 768 + h_ * 64 + fq * 8;
        qf[0] = *(const bf16x8*)qsrc; qf[1] = *(const bf16x8*)(qsrc + 32);
    }
    {
        u32x4 kvr[3], vvr[3];
#pragma unroll
        for (int i = 0; i < 3; ++i) {
            const int idx = tid + NTHR * i, key = idx >> 3, part = idx & 7;
            u32x4 kv = (u32x4){0u, 0u, 0u, 0u}, vv = (u32x4){0u, 0u, 0u, 0u};
            if (!it.samp) {
                const int tg = it.t0 - 128 + key;
                if (tg >= 0) { const bf16_t* src = u + (size_t)(it.b * SEQ + tg) * NU + kvh * 64 + part * 8; kv = *(const u32x4*)(src + 1024); vv = *(const u32x4*)(src + 1152); }
            } else if (key < 128) {
                const size_t o = ((((size_t)l * NS + it.s) * 128 + key) * 2 + kvh) * 64 + part * 8;
                kv = load8f_bf(p.cache_k + o); vv = load8f_bf(p.cache_v + o);
            } else if (key < 144) {
                const bf16_t* src = u + (size_t)(MP + it.s * LS + key - 128) * NU + kvh * 64 + part * 8; kv = *(const u32x4*)(src + 1024); vv = *(const u32x4*)(src + 1152);
            }
            kvr[i] = kv; vvr[i] = vv;
        }
#pragma unroll
        for (int i = 0; i < 3; ++i) {
            const int idx = tid + NTHR * i, key = idx >> 3, part = idx & 7;
            *(u32x4*)(Ks + key * 72 + part * 8) = kvr[i]; *(u32x4*)(Vr + key * 72 + part * 8) = vvr[i];
        }
    }
    __syncthreads();
#pragma unroll
    for (int i = 0; i < 3; ++i) {
        const int idx = tid + NTHR * i, d = idx & 63, kg = idx >> 6;
        float dummy; (void)dummy;
        unsigned short e[8];
#pragma unroll
        for (int j = 0; j < 8; ++j) e[j] = Vr[(kg * 8 + j) * 72 + d];
        u32x4 o; o[0] = e[0] | ((unsigned)e[1] << 16); o[1] = e[2] | ((unsigned)e[3] << 16); o[2] = e[4] | ((unsigned)e[5] << 16); o[3] = e[6] | ((unsigned)e[7] << 16);
        *(u32x4*)(Vt + d * 200 + kg * 8) = o;
    }
    __syncthreads();
    const int g = w >> 2, qt = w & 3, h = kvh * 2 + g;
    const bool active = qt * 16 < it.L;
    if (active) {
        f32x4 sacc[12];
#pragma unroll
        for (int kt = 0; kt < 12; ++kt) sacc[kt] = (f32x4){0.f, 0.f, 0.f, 0.f};
#pragma unroll
        for (int kt = 0; kt < 12; ++kt)
#pragma unroll
            for (int ks = 0; ks < 2; ++ks) { const bf16x8 kf = *(const bf16x8*)(Ks + (kt * 16 + fr) * 72 + ks * 32 + fq * 8); sacc[kt] = mfma16(kf, qf[ks], sacc[kt]); }
        const float slope = exp2f(-2.f * (float)(h + 1));
        const int qpos = qbase + qt * 16 + fr;
        float m = sink;
#pragma unroll
        for (int kt = 0; kt < 12; ++kt)
#pragma unroll
            for (int r = 0; r < 4; ++r) {
                const int key = kt * 16 + fq * 4 + r, kpos = kbase + key;
                const bool valid = (kpos >= 0) && (key < nkeys);
                float sv = sacc[kt][r] * 0.125f - slope * fabsf((float)(qpos - kpos));
                sv = valid ? sv : -INFINITY; sacc[kt][r] = sv; m = fmaxf(m, sv);
            }
        m = fmaxf(m, __shfl_xor(m, 16)); m = fmaxf(m, __shfl_xor(m, 32));
        float sum = 0.f;
#pragma unroll
        for (int kt = 0; kt < 12; ++kt)
#pragma unroll
            for (int r = 0; r < 4; ++r) { const float pv = __expf(sacc[kt][r] - m); sacc[kt][r] = pv; sum += pv; }
        sum += __shfl_xor(sum, 16); sum += __shfl_xor(sum, 32);
        sum += __expf(sink - m);
        bf16_t* prow = Ps + (g * 64 + qt * 16 + fr) * 200 + fq * 4;
#pragma unroll
        for (int kt = 0; kt < 12; ++kt) { u32x2 pk; pk[0] = pack_bf16(sacc[kt][0], sacc[kt][1]); pk[1] = pack_bf16(sacc[kt][2], sacc[kt][3]); *(u32x2*)(prow + kt * 16) = pk; }
        if (fq == 0) invs[w * 16 + fr] = 1.f / sum;
    }
    __syncthreads();
    if (active) {
        f32x4 o[4];
#pragma unroll
        for (int dt = 0; dt < 4; ++dt) o[dt] = (f32x4){0.f, 0.f, 0.f, 0.f};
#pragma unroll
        for (int ks = 0; ks < 6; ++ks) {
            const bf16x8 pf = *(const bf16x8*)(Ps + (g * 64 + qt * 16 + fr) * 200 + ks * 32 + fq * 8);
#pragma unroll
            for (int dt = 0; dt < 4; ++dt) { const bf16x8 vf = *(const bf16x8*)(Vt + (dt * 16 + fr) * 200 + ks * 32 + fq * 8); o[dt] = mfma16(pf, vf, o[dt]); }
        }
#pragma unroll
        for (int r = 0; r < 4; ++r) {
            const int q = qt * 16 + fq * 4 + r; const float iv = invs[w * 16 + fq * 4 + r];
            bf16_t* dst = mix + (size_t)(it.r0 + q) * D + 256 + h * 64 + fr;
#pragma unroll
            for (int dt = 0; dt < 4; ++dt) dst[dt * 16] = f2bf(o[dt][r] * iv);
        }
    }
    __syncthreads();
}

__device__ __forceinline__ void ssd1_item(const Params& p, int l, int ci, unsigned char* smem) {
    const int tid = opaque(threadIdx.x), lane = tid & 63, w = tid >> 6, fr = lane & 15, fq = lane >> 4;
    const Item it = decode_item(ci);
    bf16_t* xwT = (bf16_t*)smem;
    bf16_t* BT = (bf16_t*)(smem + 36864);
    float* dts = (float*)(smem + 55296);
    float* acs = dts + 256;
    float* wts = acs + 256;
    bf16_t* raw = (bf16_t*)(smem + 58368);
    const bf16_t* u = (const bf16_t*)(p.ws + WS_U);
    const bf16_t* xb = (const bf16_t*)(p.ws + WS_XB);
    const float* part = (const float*)(p.ws + WS_PART);
    const float* wdt = (const float*)(p.ws + WS_WDT) + (size_t)l * 4096;
    bf16_t* xcT = (bf16_t*)(p.ws + WS_XCT) + (size_t)ci * 16384;
    const int chh = tid < 384 ? tid : 0;
    const float cw0 = p.ssm_conv_w[(l * 4 + 0) * 512 + chh], cw1 = p.ssm_conv_w[(l * 4 + 1) * 512 + chh], cw2 = p.ssm_conv_w[(l * 4 + 2) * 512 + chh], cw3 = p.ssm_conv_w[(l * 4 + 3) * 512 + chh];
    const float cbias = p.ssm_conv_b[l * 512 + chh];
    const float dtb = p.ssm_dt_bias[l * 4 + ((lane >> 1) & 3)], alog = p.ssm_a_log[l * 4 + (w & 3)];
    u32x4 rv[7];
    {
        const int nrow = it.L + 3;
#pragma unroll
        for (int i = 0; i < 7; ++i) {
            const int idx = tid + NTHR * i, rr = idx / 48, pc = idx - rr * 48;
            u32x4 v = (u32x4){0u, 0u, 0u, 0u};
            if (rr < nrow) {
                if (rr >= 3 || (!it.samp && it.t0 > 0)) v = *(const u32x4*)(u + (size_t)(it.r0 + rr - 3) * NU + 256 + pc * 8);
                else if (it.samp) v = load8f_bf(p.state_ssm_conv + ((size_t)(l * NS + it.s) * 3 + rr) * 512 + pc * 8);
            }
            rv[i] = v;
        }
    }
    {
        u32x4 x0[8], x1[8];
#pragma unroll
        for (int tt = 0; tt < 8; ++tt) {
            const int t = w * 8 + tt;
            x0[tt] = (u32x4){0u, 0u, 0u, 0u}; x1[tt] = x0[tt];
            if (t < it.L) { const bf16_t* xr = xb + (size_t)(it.r0 + t) * D + lane * 16; x0[tt] = *(const u32x4*)xr; x1[tt] = *(const u32x4*)(xr + 8); }
        }
        f32x4 wv[4][4];
#pragma unroll
        for (int h = 0; h < 4; ++h)
#pragma unroll
            for (int e4 = 0; e4 < 4; ++e4) wv[h][e4] = *(const f32x4*)(wdt + h * 1024 + lane * 16 + 4 * e4);
#pragma unroll
        for (int i = 0; i < 7; ++i) { const int idx = tid + NTHR * i, rr = idx / 48, pc = idx - rr * 48; if (rr < 67) *(u32x4*)(raw + rr * 384 + pc * 8) = rv[i]; }
        float pv[32];
#pragma unroll
        for (int tt = 0; tt < 8; ++tt) {
            float xf[16];
#pragma unroll
            for (int e = 0; e < 4; ++e) { xf[2 * e] = bflo(x0[tt][e]); xf[2 * e + 1] = bfhi(x0[tt][e]); xf[8 + 2 * e] = bflo(x1[tt][e]); xf[8 + 2 * e + 1] = bfhi(x1[tt][e]); }
#pragma unroll
            for (int h = 0; h < 4; ++h) {
                float a = 0.f;
#pragma unroll
                for (int e4 = 0; e4 < 4; ++e4) a += xf[4 * e4] * wv[h][e4][0] + xf[4 * e4 + 1] * wv[h][e4][1] + xf[4 * e4 + 2] * wv[h][e4][2] + xf[4 * e4 + 3] * wv[h][e4][3];
                pv[tt * 4 + h] = a;
            }
        }
        const float mine = wave_sum_multi<32>(pv, lane);
        if ((lane & 1) == 0) {
            const int idx = lane >> 1, t = w * 8 + (idx >> 2), h = idx & 3;
            const bool ok = t < it.L; const float rs = ok ? rstd_row(part, it.r0 + t) : 0.f;
            const float rawv = mine * rs + dtb;
            dts[t * 4 + h] = ok ? (rawv > 20.f ? rawv : __logf(1.f + __expf(rawv))) : 0.f;
        }
    }
    __syncthreads();
    if (w < 4) {
        const int h = w; const float A = -__expf(alog);
        const float dtv = dts[lane * 4 + h]; float v = dtv * A;
#pragma unroll
        for (int o = 1; o < 64; o <<= 1) { const float n = __shfl_up(v, o); if (lane >= o) v += n; }
        const float endv = __shfl(v, 63);
        acs[lane * 4 + h] = v; wts[lane * 4 + h] = __expf(endv - v) * dtv;
        if (lane < it.L) { ((float*)(p.ws + WS_DT))[(size_t)(it.r0 + lane) * 4 + h] = dtv; ((float*)(p.ws + WS_AC))[(size_t)(it.r0 + lane) * 4 + h] = v; }
        if (!it.samp && lane == 0) ((float*)(p.ws + WS_DEC))[ci * 4 + h] = __expf(endv);
    }
    __syncthreads();
    if (tid < 384) {
        const int ch = tid;
        const float w0 = cw0, w1 = cw1, w2 = cw2, w3 = cw3, bias = cbias;
        const int hh = ch >> 6;
#pragma unroll 1
        for (int g = 0; g < 8; ++g) {
            float v[8], vw[8];
            if (g * 8 < it.L) {
                float xr[11];
#pragma unroll
                for (int j = 0; j < 11; ++j) xr[j] = bf2f(raw[(g * 8 + j) * 384 + ch]);
#pragma unroll
                for (int j = 0; j < 8; ++j) v[j] = siluf_(bias + w0 * xr[j] + w1 * xr[j + 1] + w2 * xr[j + 2] + w3 * xr[j + 3]);
            } else {
#pragma unroll
                for (int j = 0; j < 8; ++j) v[j] = 0.f;
            }
            if (ch < 256) {
                *(u32x4*)(xcT + ch * 64 + g * 8) = pack8(v);
#pragma unroll
                for (int j = 0; j < 8; ++j) vw[j] = v[j] * wts[(g * 8 + j) * 4 + hh];
                *(u32x4*)(xwT + ch * 72 + g * 8) = pack8(vw);
            } else *(u32x4*)(BT + (ch - 256) * 72 + g * 8) = pack8(v);
        }
    }
    __syncthreads();
    {
        const int h = w >> 1, ph = w & 1;
        f32x4 acc[2][8];
#pragma unroll
        for (int i = 0; i < 2; ++i)
#pragma unroll
            for (int j = 0; j < 8; ++j) acc[i][j] = (f32x4){0.f, 0.f, 0.f, 0.f};
#pragma unroll
        for (int ks = 0; ks < 2; ++ks) {
            bf16x8 xf[2];
#pragma unroll
            for (int pt = 0; pt < 2; ++pt) xf[pt] = *(const bf16x8*)(xwT + (h * 64 + ph * 32 + pt * 16 + fr) * 72 + ks * 32 + fq * 8);
#pragma unroll
            for (int nt = 0; nt < 8; ++nt) {
                const bf16x8 bfr = *(const bf16x8*)(BT + (nt * 16 + fr) * 72 + ks * 32 + fq * 8);
#pragma unroll
                for (int pt = 0; pt < 2; ++pt) acc[pt][nt] = mfma16(bfr, xf[pt], acc[pt][nt]);
            }
        }
        const float dec = __expf(acs[63 * 4 + h]);
#pragma unroll
        for (int pt = 0; pt < 2; ++pt)
#pragma unroll
            for (int nt = 0; nt < 8; ++nt) {
                const int pp = ph * 32 + pt * 16 + fr, n = nt * 16 + fq * 4;
                if (!it.samp) *(f32x4*)((float*)(p.ws + WS_S) + (((size_t)ci * 4 + h) * 64 + pp) * 128 + n) = acc[pt][nt];
                else { const size_t o = (((size_t)(l * NS + it.s) * 4 + h) * 64 + pp) * 128 + n; const f32x4 h0 = *(const f32x4*)(p.state_ssm + o); *(f32x4*)(p.out + O_SSM_S + o) = h0 * dec + acc[pt][nt]; }
            }
    }
    __syncthreads();
}

__device__ __forceinline__ void ssd3_item(const Params& p, int l, int ci, unsigned char* smem) {
    const int tid = opaque(threadIdx.x), lane = tid & 63, w = tid >> 6, fr = lane & 15, fq = lane >> 4;
    const Item it = decode_item(ci);
    bf16_t* xT = (bf16_t*)smem;
    bf16_t* Bm = (bf16_t*)(smem + 36864);
    bf16_t* Cm = (bf16_t*)(smem + 54272);
    bf16_t* G = (bf16_t*)(smem + 71680);
    float* yg = (float*)(smem + 36864);
    float* dts = (float*)(smem + 108544);
    float* acs = dts + 256;
    const bf16_t* u = (const bf16_t*)(p.ws + WS_U);
    bf16_t* mix = (bf16_t*)(p.ws + WS_MIX);
    bf16x8 hfr[4][4];
    {
        const int hh_ = w >> 1;
        if (it.samp) {
            const float* hs = p.state_ssm + ((size_t)(l * NS + it.s) * 4 + hh_) * 8192;
#pragma unroll
            for (int ks = 0; ks < 4; ++ks)
#pragma unroll
                for (int pt = 0; pt < 4; ++pt) hfr[ks][pt] = __builtin_bit_cast(bf16x8, load8f_bf(hs + (size_t)(pt * 16 + fr) * 128 + ks * 32 + fq * 8));
        } else {
            const bf16_t* hs = (const bf16_t*)(p.ws + WS_XC) + ((size_t)ci * 4 + hh_) * 8192;
#pragma unroll
            for (int ks = 0; ks < 4; ++ks)
#pragma unroll
                for (int pt = 0; pt < 4; ++pt) hfr[ks][pt] = *(const bf16x8*)(hs + (size_t)(pt * 16 + fr) * 128 + ks * 32 + fq * 8);
        }
    }
    bf16_t* raw2 = G;
    const int cc_ = 256 + (tid & 255);
    const float cw0 = p.ssm_conv_w[(l * 4 + 0) * 512 + cc_], cw1 = p.ssm_conv_w[(l * 4 + 1) * 512 + cc_], cw2 = p.ssm_conv_w[(l * 4 + 2) * 512 + cc_], cw3 = p.ssm_conv_w[(l * 4 + 3) * 512 + cc_];
    const float cbias = p.ssm_conv_b[l * 512 + cc_];
    const float dsk = p.ssm_d[l * 4 + (w >> 1)];
    const f32x4 gn = *(const f32x4*)(p.ssm_norm + l * 256 + lane * 4);
    {
        const bf16_t* xcT = (const bf16_t*)(p.ws + WS_XCT) + (size_t)ci * 16384;
        const int nrow = it.L + 3;
        u32x4 xv[4], rv[5];
#pragma unroll
        for (int i = 0; i < 4; ++i) xv[i] = *(const u32x4*)(xcT + (tid + NTHR * i) * 8);
#pragma unroll
        for (int i = 0; i < 5; ++i) {
            const int idx = tid + NTHR * i, rr = idx >> 5, pc = idx & 31;
            u32x4 v = (u32x4){0u, 0u, 0u, 0u};
            if (rr < nrow) {
                if (rr >= 3 || (!it.samp && it.t0 > 0)) v = *(const u32x4*)(u + (size_t)(it.r0 + rr - 3) * NU + 512 + pc * 8);
                else if (it.samp) v = load8f_bf(p.state_ssm_conv + ((size_t)(l * NS + it.s) * 3 + rr) * 512 + 256 + pc * 8);
            }
            rv[i] = v;
        }
#pragma unroll
        for (int i = 0; i < 4; ++i) { const int idx = tid + NTHR * i; *(u32x4*)(xT + (idx >> 3) * 72 + (idx & 7) * 8) = xv[i]; }
#pragma unroll
        for (int i = 0; i < 5; ++i) { const int idx = tid + NTHR * i, rr = idx >> 5, pc = idx & 31; if (rr < 67) *(u32x4*)(raw2 + rr * 256 + pc * 8) = rv[i]; }
    }
    if (tid < 256) {
        const int t = tid >> 2;
        dts[tid] = t < it.L ? ((const float*)(p.ws + WS_DT))[(size_t)it.r0 * 4 + tid] : 0.f;
        acs[tid] = t < it.L ? ((const float*)(p.ws + WS_AC))[(size_t)it.r0 * 4 + tid] : 0.f;
    }
    __syncthreads();
    {
        const int ch = tid & 255, th = tid >> 8;
        const float w0 = cw0, w1 = cw1, w2 = cw2, w3 = cw3, bias = cbias;
        bf16_t* dstm = ch < 128 ? Bm + ch : Cm + (ch - 128);
#pragma unroll 1
        for (int g = 0; g < 4; ++g) {
            const int tb = th * 32 + g * 8;
            if (tb < it.L) {
                float xr[11];
#pragma unroll
                for (int j = 0; j < 11; ++j) xr[j] = bf2f(raw2[(tb + j) * 256 + ch]);
#pragma unroll
                for (int j = 0; j < 8; ++j) dstm[(tb + j) * 136] = f2bf(siluf_(bias + w0 * xr[j] + w1 * xr[j + 1] + w2 * xr[j + 2] + w3 * xr[j + 3]));
            } else {
#pragma unroll
                for (int j = 0; j < 8; ++j) dstm[(tb + j) * 136] = 0;
            }
        }
    }
    __syncthreads();
    {
        const int itl = w & 3, jh = w >> 2;
        f32x4 cb[2]; cb[0] = (f32x4){0.f, 0.f, 0.f, 0.f}; cb[1] = cb[0];
#pragma unroll
        for (int ks = 0; ks < 4; ++ks) {
            const bf16x8 cf = *(const bf16x8*)(Cm + (itl * 16 + fr) * 136 + ks * 32 + fq * 8);
#pragma unroll
            for (int jj = 0; jj < 2; ++jj) { const bf16x8 bfr = *(const bf16x8*)(Bm + ((jh * 2 + jj) * 16 + fr) * 136 + ks * 32 + fq * 8); cb[jj] = mfma16(bfr, cf, cb[jj]); }
        }
        const int i = itl * 16 + fr;
#pragma unroll
        for (int h = 0; h < 4; ++h) {
            const float ai = acs[i * 4 + h];
#pragma unroll
            for (int jj = 0; jj < 2; ++jj) {
                const int j0 = (jh * 2 + jj) * 16 + fq * 4;
                float gv[4];
#pragma unroll
                for (int r = 0; r < 4; ++r) { const int j = j0 + r; gv[r] = (j <= i) ? cb[jj][r] * __expf(ai - acs[j * 4 + h]) * dts[j * 4 + h] : 0.f; }
                u32x2 pk; pk[0] = pack_bf16(gv[0], gv[1]); pk[1] = pack_bf16(gv[2], gv[3]);
                *(u32x2*)(G + (h * 64 + i) * 72 + j0) = pk;
            }
        }
    }
    __syncthreads();
    const int h = w >> 1, ih = w & 1;
    f32x4 yi[2][4], ye[2][4];
#pragma unroll
    for (int a = 0; a < 2; ++a)
#pragma unroll
        for (int b = 0; b < 4; ++b) { yi[a][b] = (f32x4){0.f, 0.f, 0.f, 0.f}; ye[a][b] = yi[a][b]; }
#pragma unroll
    for (int ks = 0; ks < 2; ++ks) {
        bf16x8 gf[2];
#pragma unroll
        for (int a = 0; a < 2; ++a) gf[a] = *(const bf16x8*)(G + (h * 64 + (ih * 2 + a) * 16 + fr) * 72 + ks * 32 + fq * 8);
#pragma unroll
        for (int pt = 0; pt < 4; ++pt) {
            const bf16x8 xf = *(const bf16x8*)(xT + (h * 64 + pt * 16 + fr) * 72 + ks * 32 + fq * 8);
#pragma unroll
            for (int a = 0; a < 2; ++a) yi[a][pt] = mfma16(gf[a], xf, yi[a][pt]);
        }
    }
#pragma unroll
    for (int ks = 0; ks < 4; ++ks) {
        bf16x8 cf[2];
#pragma unroll
        for (int a = 0; a < 2; ++a) cf[a] = *(const bf16x8*)(Cm + ((ih * 2 + a) * 16 + fr) * 136 + ks * 32 + fq * 8);
#pragma unroll
        for (int pt = 0; pt < 4; ++pt)
#pragma unroll
            for (int a = 0; a < 2; ++a) ye[a][pt] = mfma16(cf[a], hfr[ks][pt], ye[a][pt]);
    }
#pragma unroll
    for (int a = 0; a < 2; ++a)
#pragma unroll
        for (int r = 0; r < 4; ++r) {
            const int i = (ih * 2 + a) * 16 + fq * 4 + r; const float ea = __expf(acs[i * 4 + h]);
#pragma unroll
            for (int pt = 0; pt < 4; ++pt) {
                const int pp = pt * 16 + fr;
                const float xv = bf2f(xT[(h * 64 + pp) * 72 + i]);
                yi[a][pt][r] = yi[a][pt][r] + ea * ye[a][pt][r] + dsk * xv;
            }
        }
    u32x2 zz[8];
#pragma unroll
    for (int tt = 0; tt < 8; ++tt) { const int t = w * 8 + tt; zz[tt] = (u32x2){0u, 0u}; if (t < it.L) zz[tt] = *(const u32x2*)(u + (size_t)(it.r0 + t) * NU + lane * 4); }
    __syncthreads();
#pragma unroll
    for (int a = 0; a < 2; ++a)
#pragma unroll
        for (int r = 0; r < 4; ++r) {
            const int i = (ih * 2 + a) * 16 + fq * 4 + r;
#pragma unroll
            for (int pt = 0; pt < 4; ++pt) yg[i * 256 + h * 64 + pt * 16 + fr] = yi[a][pt][r];
        }
    __syncthreads();
    {
        f32x4 vv[8]; float sq[8];
#pragma unroll
        for (int tt = 0; tt < 8; ++tt) {
            f32x4 v = *(const f32x4*)(yg + (w * 8 + tt) * 256 + lane * 4);
            v[0] *= siluf_(bflo(zz[tt][0])); v[1] *= siluf_(bfhi(zz[tt][0])); v[2] *= siluf_(bflo(zz[tt][1])); v[3] *= siluf_(bfhi(zz[tt][1]));
            vv[tt] = v; sq[tt] = v[0] * v[0] + v[1] * v[1] + v[2] * v[2] + v[3] * v[3];
        }
        const float tot = wave_sum_multi<8>(sq, lane);
#pragma unroll
        for (int tt = 0; tt < 8; ++tt) {
            const int t = w * 8 + tt;
            const float rs = rsqrtf(__shfl(tot, tt * 8) * (1.f / 256.f) + EPS);
            if (t < it.L) {
                const f32x4 v = vv[tt];
                u32x2 pk; pk[0] = pack_bf16(v[0] * rs * gn[0], v[1] * rs * gn[1]); pk[1] = pack_bf16(v[2] * rs * gn[2], v[3] * rs * gn[3]);
                *(u32x2*)(mix + (size_t)(it.r0 + t) * D + lane * 4) = pk;
            }
        }
    }
    __syncthreads();
}

__device__ __forceinline__ void sconv_item(const Params& p, int l, int ci) {
    const int tid = opaque(threadIdx.x), cgp = tid & 31, tq = tid >> 5, c0 = cgp * 8;
    const Item it = decode_item(ci);
    const bf16_t* u = (const bf16_t*)(p.ws + WS_U);
    bf16_t* mix = (bf16_t*)(p.ws + WS_MIX);
    const int nt = it.L >> 4, ts = tq * nt;
    float w0[8], w1[8], w2[8];
#pragma unroll
    for (int k4 = 0; k4 < 2; ++k4) {
        const f32x4 a = *(const f32x4*)(p.sconv_w + (l * 3 + 0) * 256 + c0 + 4 * k4), b = *(const f32x4*)(p.sconv_w + (l * 3 + 1) * 256 + c0 + 4 * k4), c = *(const f32x4*)(p.sconv_w + (l * 3 + 2) * 256 + c0 + 4 * k4);
#pragma unroll
        for (int e = 0; e < 4; ++e) { w0[4 * k4 + e] = a[e]; w1[4 * k4 + e] = b[e]; w2[4 * k4 + e] = c[e]; }
    }
    u32x4 cgv[6], bgv[4];
    f32x4 st0[2], st1[2];
    const bool need_state = it.samp && ts < 2;
#pragma unroll
    for (int j = 0; j < 6; ++j) {
        cgv[j] = (u32x4){0u, 0u, 0u, 0u};
        const int tl = ts - 2 + j;
        if (j < nt + 2 && (tl >= 0 || (!it.samp && it.t0 + tl >= 0))) { const bf16_t* ur = u + (size_t)(it.r0 + tl) * NU + c0; cgv[j] = *(const u32x4*)(ur + 1536); }
    }
#pragma unroll
    for (int j = 0; j < 2; ++j) {
        st0[j] = (f32x4){0.f, 0.f, 0.f, 0.f}; st1[j] = st0[j];
        if (need_state && ts - 2 + j < 0) { const float* sp = p.state_sconv + ((size_t)(l * NS + it.s) * 2 + (ts + j)) * 256 + c0; st0[j] = *(const f32x4*)sp; st1[j] = *(const f32x4*)(sp + 4); }
    }
#pragma unroll
    for (int j = 0; j < 4; ++j) { bgv[j] = (u32x4){0u, 0u, 0u, 0u}; if (j < nt) bgv[j] = *(const u32x4*)(u + (size_t)(it.r0 + ts + j) * NU + 1280 + c0); }
    float pv[6][8];
#pragma unroll
    for (int j = 0; j < 6; ++j)
#pragma unroll
        for (int q = 0; q < 4; ++q) { pv[j][2 * q] = bflo(cgv[j][q]); pv[j][2 * q + 1] = bfhi(cgv[j][q]); }
#pragma unroll
    for (int j = 0; j < 2; ++j)
        if (need_state && ts - 2 + j < 0) {
#pragma unroll
            for (int e = 0; e < 4; ++e) { pv[j][e] = st0[j][e]; pv[j][4 + e] = st1[j][e]; }
        }
    const bool wr_state = it.samp || it.c == 63;
    float* sdst = it.samp ? p.out + O_SC_S + (size_t)(l * NS + it.s) * 512 + c0 : p.out + O_SC_P + (size_t)(l * NB + it.b) * 512 + c0;
#pragma unroll
    for (int j = 0; j < 4; ++j) {
        if (j < nt) {
            const int t = ts + j;
            float o[8];
#pragma unroll
            for (int q = 0; q < 4; ++q) {
                o[2 * q] = bflo(bgv[j][q]) * (w0[2 * q] * pv[j][2 * q] + w1[2 * q] * pv[j + 1][2 * q] + w2[2 * q] * pv[j + 2][2 * q]);
                o[2 * q + 1] = bfhi(bgv[j][q]) * (w0[2 * q + 1] * pv[j][2 * q + 1] + w1[2 * q + 1] * pv[j + 1][2 * q + 1] + w2[2 * q + 1] * pv[j + 2][2 * q + 1]);
            }
            *(u32x4*)(mix + (size_t)(it.r0 + t) * D + 512 + c0) = pack8(o);
            if (wr_state && t >= it.L - 2) {
                float* d = sdst + (t - (it.L - 2)) * 256;
                *(f32x4*)d = (f32x4){pv[j + 2][0], pv[j + 2][1], pv[j + 2][2], pv[j + 2][3]}; *(f32x4*)(d + 4) = (f32x4){pv[j + 2][4], pv[j + 2][5], pv[j + 2][6], pv[j + 2][7]};
            }
        }
    }
}

__device__ __forceinline__ void cconv_item(const Params& p, int l, int ci, unsigned char* smem) {
    const int tid = opaque(threadIdx.x), lane = tid & 63, w = tid >> 6;
    const Item it = decode_item(ci);
    bf16_t* gl = (bf16_t*)smem;
    float* yb = (float*)(smem + 49152);
    const bf16_t* u = (const bf16_t*)(p.ws + WS_U);
    bf16_t* mix = (bf16_t*)(p.ws + WS_MIX);
    const int nrows = 30 + it.L;
    float wk[31];
#pragma unroll
    for (int k = 0; k < 31; ++k) wk[k] = p.cconv_w[(l * 31 + k) * 256 + (tid & 255)];
    const float bias = p.cconv_b[l * 256 + (tid & 255)];
    const f32x4 gn = *(const f32x4*)(p.cconv_ln_g + l * 256 + lane * 4), bn = *(const f32x4*)(p.cconv_ln_b + l * 256 + lane * 4);
    {
        u32x4 av[6];
#pragma unroll
        for (int i = 0; i < 6; ++i) {
            const int idx = tid + NTHR * i, li = idx >> 5, part = idx & 31, tg = it.t0 - 30 + li;
            av[i] = (u32x4){0u, 0u, 0u, 0u};
            if (li < nrows) {
                if (tg >= 0) { const bf16_t* ur = u + (size_t)(it.r0 - it.t0 + tg) * NU + part * 8; av[i] = *(const u32x4*)(ur + 1792); }
                else if (it.samp) { const float* sb = p.state_cconv + ((size_t)(l * NS + it.s) * 30 + li) * 256 + part * 8; av[i] = load8f_bf(sb); }
            }
        }
#pragma unroll
        for (int i = 0; i < 6; ++i) {
            const int idx = tid + NTHR * i, li = idx >> 5, part = idx & 31;
            if (li < nrows) *(u32x4*)(gl + li * 256 + part * 8) = av[i];
        }
    }
    __syncthreads();
    if (it.samp || it.c == 63) {
        float* dst = it.samp ? p.out + O_CC_S + (size_t)(l * NS + it.s) * 7680 : p.out + O_CC_P + (size_t)(l * NB + it.b) * 7680;
        for (int idx = tid; idx < 7680; idx += NTHR) dst[idx] = bf2f(gl[it.L * 256 + idx]);
    }
    {
        const int ch = tid & 255, th = tid >> 8, nt = it.L / 2;
#pragma unroll 1
        for (int tb = th * nt; tb < th * nt + nt; tb += 8) {
            float xr[38];
#pragma unroll
            for (int j = 0; j < 38; ++j) xr[j] = bf2f(gl[(tb + j) * 256 + ch]);
#pragma unroll
            for (int j = 0; j < 8; ++j) {
                float a = bias;
#pragma unroll
                for (int k = 0; k < 31; ++k) a += wk[k] * xr[j + k];
                yb[(tb + j) * 256 + ch] = a;
            }
        }
    }
    __syncthreads();
    {
        f32x4 vv[8]; float sm[8];
#pragma unroll
        for (int tt = 0; tt < 8; ++tt) { vv[tt] = *(const f32x4*)(yb + (w * 8 + tt) * 256 + lane * 4); sm[tt] = (vv[tt][0] + vv[tt][1]) + (vv[tt][2] + vv[tt][3]); }
        const float tsum = wave_sum_multi<8>(sm, lane);
#pragma unroll
        for (int tt = 0; tt < 8; ++tt) {
            const float mean = __shfl(tsum, tt * 8) * (1.f / 256.f);
            vv[tt] = vv[tt] - mean;
            sm[tt] = (vv[tt][0] * vv[tt][0] + vv[tt][1] * vv[tt][1]) + (vv[tt][2] * vv[tt][2] + vv[tt][3] * vv[tt][3]);
        }
        const float tsq = wave_sum_multi<8>(sm, lane);
#pragma unroll
        for (int tt = 0; tt < 8; ++tt) {
            const int t = w * 8 + tt;
            const float rs = rsqrtf(__shfl(tsq, tt * 8) * (1.f / 256.f) + EPS);
            if (t < it.L) {
                float o[4];
#pragma unroll
                for (int e = 0; e < 4; ++e) o[e] = siluf_(vv[tt][e] * rs * gn[e] + bn[e]);
                u32x2 pk; pk[0] = pack_bf16(o[0], o[1]); pk[1] = pack_bf16(o[2], o[3]);
                *(u32x2*)(mix + (size_t)(it.r0 + t) * D + 768 + lane * 4) = pk;
            }
        }
    }
    __syncthreads();
}

__device__ __forceinline__ void state_copies(const Params& p, int l) {
    const bf16_t* u = (const bf16_t*)(p.ws + WS_U);
    const int gt = blockIdx.x * NTHR + opaque(threadIdx.x), gs = gridDim.x * NTHR;
    for (int e = gt; e < 65536; e += gs) {
        const int b = e >> 14, i = (e >> 7) & 127, cd = e & 127;
        const bf16_t* src = u + (size_t)(b * SEQ + SEQ - 128 + i) * NU + cd;
        p.out[O_K_P + (size_t)l * 65536 + e] = bf2f(src[1024]); p.out[O_V_P + (size_t)l * 65536 + e] = bf2f(src[1152]);
        const int s = e >> 11, t = (e >> 7) & 15;
        const bf16_t* src2 = u + (size_t)(MP + s * LS + t) * NU + cd;
        p.out[O_K_S + (size_t)l * 65536 + e] = bf2f(src2[1024]); p.out[O_V_S + (size_t)l * 65536 + e] = bf2f(src2[1152]);
    }
    for (int e = gt; e < 6144; e += gs) {
        const int b = e / 1536, i = (e / 512) % 3, ch = e & 511;
        p.out[O_SCV_P + (size_t)l * 6144 + e] = bf2f(u[(size_t)(b * SEQ + SEQ - 3 + i) * NU + 256 + ch]);
    }
    for (int e = gt; e < 49152; e += gs) {
        const int s = e / 1536, i = (e / 512) % 3, ch = e & 511;
        p.out[O_SCV_S + (size_t)l * 49152 + e] = bf2f(u[(size_t)(MP + s * LS + LS - 3 + i) * NU + 256 + ch]);
    }
}

__global__ void __launch_bounds__(NTHR, 2) mega(Params p0, int ph_lo, int ph_hi) {
    extern __shared__ __attribute__((aligned(16))) unsigned char smem[];
    if (threadIdx.x < 4) ((volatile unsigned*)(smem + LDS_BYTES))[threadIdx.x] = 0u;
    __syncthreads();
    XcdBarrier xb = xcd_barrier_post((unsigned*)(p0.ws + WS_BAR), (volatile LAS unsigned*)(smem + LDS_BYTES));
    for (int ph = ph_lo; ph < ph_hi; ++ph) {
        if (ph > ph_lo) { xcd_barrier(xb); }
        Params p = p0;
        { size_t z0 = 0, z1 = 0; asm volatile("" : "+s"(z0), "+s"(z1)); p.ws = p0.ws + z0; p.out = p0.out + z1; }
        const int tid = opaque(threadIdx.x);
        const int spid = ph == 0 ? 100 : (ph == NPH - 1 ? 101 : (ph - 1) % 7);
#if RPT_SP >= 0
        const int nrep = (spid == RPT_SP) ? RPT_N + 1 : 1;
        for (int rep = 0; rep < nrep; ++rep)
#else
        (void)spid;
#endif
        if (ph == 0) {
            int it = blockIdx.x;
            for (; it < 161; it += gridDim.x) {
                const PrepT t = prep_decode(it < 160 ? it : 752);
                const V8 v = prep_load(p, t, tid);
                prep_finish(p, t, tid, v, smem);
            }
            __syncthreads();
            {
                int r = it - 161; const int nr = MT / 8;
                Row4 cur = init_rows_load(p, r < nr ? r : 0, tid);
                for (; r < nr; r += gridDim.x) {
                    const int rn = r + gridDim.x;
                    const Row4 nxt = init_rows_load(p, rn < nr ? rn : r, tid);
                    init_rows_finish(p, r, tid, cur);
                    cur = nxt;
                }
            }
        } else if (ph == NPH - 1) {
            const float* part = (const float*)(p.ws + WS_PART);
            const int lane = tid & 63, w = tid >> 6;
            for (int it = blockIdx.x; it < MT / 8; it += gridDim.x) {
                const int row = it * 8 + w; const float rs = rstd_row(part, row);
                float* Y = p.out + (size_t)row * D; const bf16_t* xr = (const bf16_t*)(p.ws + WS_XB) + (size_t)row * D;
#pragma unroll
                for (int i = 0; i < 4; ++i) {
                    const int c = i * 256 + lane * 4;
                    const u32x2 xv = *(const u32x2*)(xr + c); const f32x4 g = *(const f32x4*)(p.norm_final + c);
                    f32x4 v; v[0] = bflo(xv[0]) * rs * g[0]; v[1] = bfhi(xv[0]) * rs * g[1]; v[2] = bflo(xv[1]) * rs * g[2]; v[3] = bfhi(xv[1]) * rs * g[3];
                    *(f32x4*)(Y + c) = v;
                }
            }
        } else {
            const int l = (ph - 1) / 7, sp = (ph - 1) % 7;
            const bf16_t* xb = (const bf16_t*)(p.ws + WS_XB);
            float* part = (float*)(p.ws + WS_PART);
            if (sp == 0) {
                EpiU e{(bf16_t*)(p.ws + WS_U), rstd_table_ptr(smem)};
                if (EN(7)) run_gemm(xb, (const bf16_t*)(p.ws + WS_WIN + l * W_IN_B), MT, NW, D, e, smem, PreRstd{part, MT, NW, rstd_table_ptr(smem)});
                prep_in_idle_slots(p, (MT / 256) * (NW / 256), l * 753 + 160, l * 753 + 576, 0, 0, -1, smem);
            } else if (sp == 1) {
                unsigned* ctr = (unsigned*)(p.ws + WS_BAR) + 32 * (l + 1);
                volatile int* slot = (volatile int*)(smem + LDS_BYTES + 8);
                int pre = 0;
                if (tid == 0) pre = (int)__hip_atomic_fetch_add(ctr, 1u, __ATOMIC_RELAXED, __HIP_MEMORY_SCOPE_AGENT);
                for (;;) {
                    __syncthreads();
                    if (tid == 0) *slot = pre;
                    __syncthreads();
                    const int it = *slot;
                    if (it >= 1440) break;
                    if (tid == 0) pre = (int)__hip_atomic_fetch_add(ctr, 1u, __ATOMIC_RELAXED, __HIP_MEMORY_SCOPE_AGENT);
                    if (it < 32) { ssd1_item(p, l, 256 + it, smem); ssd3_item(p, l, 256 + it, smem); }
                    else if (it < 320) cconv_item(p, l, it - 32, smem);
                    else if (it < 576) ssd1_item(p, l, it - 320, smem);
                    else if (it < 864) sconv_item(p, l, it - 576);
                    else swa_item(p, l, (it - 864) >> 1, (it - 864) & 1, smem);
                }
            } else if (sp == 2) {
                state_copies(p, l);
                const float* S = (const float*)(p.ws + WS_S); const float* dec = (const float*)(p.ws + WS_DEC);
                bf16_t* Hb = (bf16_t*)(p.ws + WS_XC);
                for (int e = blockIdx.x * NTHR + tid; e < 131072; e += gridDim.x * NTHR) {
                    const int b = e >> 15, rem = e & 32767, h = rem >> 13;
                    float hc = 0.f;
                    float sv[64];
#pragma unroll
                    for (int j = 0; j < 64; ++j) sv[j] = S[(size_t)(b * 64 + j) * 32768 + rem];
#pragma unroll
                    for (int c0 = 0; c0 < 64; c0 += 16) {
                        float dv[16];
#pragma unroll
                        for (int j = 0; j < 16; ++j) dv[j] = dec[(b * 64 + c0 + j) * 4 + h];
#pragma unroll
                        for (int j = 0; j < 16; ++j) { Hb[(size_t)(b * 64 + c0 + j) * 32768 + rem] = f2bf(hc); hc = dv[j] * hc + sv[c0 + j]; }
                    }
                    p.out[O_SSM_P + (size_t)(l * NB + b) * 32768 + rem] = hc;
                }
            } else if (sp == 3) {
                for (int it = blockIdx.x; it < 256; it += gridDim.x) if (EN(6)) ssd3_item(p, l, it, smem);
            } else if (sp == 4) {
                EpiRes e{(bf16_t*)(p.ws + WS_XB), part};
                if (EN(8)) { run_gemm((const bf16_t*)(p.ws + WS_MIX), (const bf16_t*)(p.ws + WS_WOUT + l * W_OUT_B), MP, D, D, e, smem, PreNone{});
                    gemm_small_res((const bf16_t*)(p.ws + WS_MIX), (const bf16_t*)(p.ws + WS_WOUT + l * W_OUT_B), D, (bf16_t*)(p.ws + WS_XB), part, smem); }
            } else if (sp == 5) {
                EpiGlu e{(bf16_t*)(p.ws + WS_U), rstd_table_ptr(smem)};
                if (EN(9)) run_gemm(xb, (const bf16_t*)(p.ws + WS_WGU + l * W_GU_B), MT, NGU, D, e, smem, PreRstd{part, MT, NGU, rstd_table_ptr(smem)});
                if (l == 0) prep_in_idle_slots(p, (MT / 256) * (NGU / 256), 576, 752, 753, 753 + 160, 753 + 752, smem);
                else prep_in_idle_slots(p, (MT / 256) * (NGU / 256), 753 + 576, 753 + 752, 0, 0, -1, smem);
            } else {
                EpiRes e{(bf16_t*)(p.ws + WS_XB), part};
                if (EN(10)) { run_gemm((const bf16_t*)(p.ws + WS_U), (const bf16_t*)(p.ws + WS_WDN + l * W_DN_B), MP, D, DFF, e, smem, PreNone{});
                    gemm_small_res((const bf16_t*)(p.ws + WS_U), (const bf16_t*)(p.ws + WS_WDN + l * W_DN_B), DFF, (bf16_t*)(p.ws + WS_XB), part, smem); }
            }
        }
    }
}

extern "C" void kernel_launch(void* const* d_in, const int* in_sizes, int n_in, void* d_out, int out_size, void* d_ws, size_t ws_size, hipStream_t stream) {
    static int grid = 0;
    if (grid == 0) {
        if (n_in != 28 || ws_size < WS_END || (size_t)out_size != O_END) { fprintf(stderr, "kernel_launch: unexpected shapes (n_in %d, out %d, ws %zu)\n", n_in, out_size, ws_size); grid = -1; return; }
        int dev = 0, cus = 0, per_cu = 0;
        hipGetDevice(&dev); hipDeviceGetAttribute(&cus, hipDeviceAttributeMultiprocessorCount, dev);
        if (hipFuncSetAttribute((const void*)mega, hipFuncAttributeMaxDynamicSharedMemorySize, LDS_TOTAL) != hipSuccess) { fprintf(stderr, "hipFuncSetAttribute failed\n"); grid = -1; return; }
        if (hipOccupancyMaxActiveBlocksPerMultiprocessor(&per_cu, (const void*)mega, NTHR, LDS_TOTAL) != hipSuccess || per_cu < 1) { fprintf(stderr, "occupancy query failed (%d)\n", per_cu); grid = -1; return; }
        grid = cus * 1;
    }
    if (grid < 0) return;
    if (hipMemsetAsync((unsigned char*)d_ws + WS_BAR, 0, 16384, stream) != hipSuccess) { fprintf(stderr, "memset failed\n"); return; }
    Params p{};
    const float** pp = (const float**)&p;
    for (int i = 0; i < 28; ++i) pp[i] = (const float*)d_in[i];
    p.out = (float*)d_out; p.ws = (unsigned char*)d_ws;
#if MK_MULTI
    for (int ph = 0; ph < NPH; ++ph) hipLaunchKernelGGL(mega, dim3(grid), dim3(NTHR), LDS_TOTAL, stream, p, ph, ph + 1);
#else
    int lo = 0, hi = NPH;
    void* args[] = {&p, &lo, &hi};
    hipError_t e = hipLaunchCooperativeKernel((const void*)mega, dim3(grid), dim3(NTHR), args, LDS_TOTAL, stream);
    if (e != hipSuccess) fprintf(stderr, "cooperative launch failed: %s (grid %d)\n", hipGetErrorString(e), grid);
#endif
}
```

```cpp
#include <hip/hip_runtime.h>
#include <hip/hip_cooperative_groups.h>
#include <cstdio>
namespace cg = cooperative_groups;

#ifndef ONLY
#define ONLY -1
#endif
#define EN(k) (ONLY < 0 || ONLY == (k))
#ifndef RPT_SP
#define RPT_SP -1
#endif
#ifndef RPT_ITEM
#define RPT_ITEM -1
#endif
#define NR(k) ((RPT_ITEM == (k)) ? 2 : 1)
#ifndef RPT_N
#define RPT_N 1
#endif
#ifndef MK_MULTI
#define MK_MULTI 0
#endif

typedef unsigned short bf16_t;
typedef short bf16x8 __attribute__((ext_vector_type(8)));
typedef float f32x4 __attribute__((ext_vector_type(4)));
typedef unsigned u32x4 __attribute__((ext_vector_type(4)));
typedef unsigned u32x2 __attribute__((ext_vector_type(2)));

constexpr int D = 1024, NB = 4, SEQ = 4096, NS = 32, LS = 16, PAST = 1024;
constexpr int MP = NB * SEQ, MS = NS * LS, MT = MP + MS;
constexpr int NU = 2048, NW = 2560, DIN = 2564, DFF = 2816, NGU = 2 * DFF;
constexpr int NCI = 256 + NS;
constexpr float EPS = 1e-5f;
constexpr int NTHR = 512;
constexpr int LDS_BYTES = 128 * 1024;
constexpr int NPH = 16;
constexpr int LDS_TOTAL = LDS_BYTES + 64 + 16384;

constexpr size_t O_Y = 0;
constexpr size_t O_SSM_P = (size_t)MT * D;
constexpr size_t O_SSM_S = O_SSM_P + 2 * 4 * 4 * 64 * 128;
constexpr size_t O_SCV_P = O_SSM_S + 2 * 32 * 4 * 64 * 128;
constexpr size_t O_SCV_S = O_SCV_P + 2 * 4 * 3 * 512;
constexpr size_t O_K_P = O_SCV_S + 2 * 32 * 3 * 512;
constexpr size_t O_K_S = O_K_P + 2 * 4 * 128 * 128;
constexpr size_t O_V_P = O_K_S + 2 * 32 * 16 * 128;
constexpr size_t O_V_S = O_V_P + 2 * 4 * 128 * 128;
constexpr size_t O_SC_P = O_V_S + 2 * 32 * 16 * 128;
constexpr size_t O_SC_S = O_SC_P + 2 * 4 * 2 * 256;
constexpr size_t O_CC_P = O_SC_S + 2 * 32 * 2 * 256;
constexpr size_t O_CC_S = O_CC_P + 2 * 4 * 30 * 256;
constexpr size_t O_END = O_CC_S + 2 * 32 * 30 * 256;
static_assert(O_END == 20885504, "output size");

constexpr size_t W_IN_B = (size_t)NW * D * 2, W_OUT_B = (size_t)D * D * 2, W_GU_B = (size_t)NGU * D * 2, W_DN_B = (size_t)D * DFF * 2;
constexpr size_t WS_WIN = 0;
constexpr size_t WS_WOUT = WS_WIN + 2 * W_IN_B;
constexpr size_t WS_WGU = WS_WOUT + 2 * W_OUT_B;
constexpr size_t WS_WDN = WS_WGU + 2 * W_GU_B;
constexpr size_t WS_WDT = WS_WDN + 2 * W_DN_B;
constexpr size_t WS_XB = WS_WDT + 2 * 4 * 1024 * 4;
constexpr size_t WS_PART = WS_XB + (size_t)MT * D * 2;
constexpr size_t WS_DT = WS_PART + (size_t)MT * 16 * 4;
constexpr size_t WS_AC = WS_DT + (size_t)MT * 4 * 4;
constexpr size_t WS_DEC = WS_AC + (size_t)MT * 4 * 4;
constexpr size_t WS_U = WS_DEC + 4096;
constexpr size_t WS_XC = WS_U + (size_t)MT * NW * 2;
constexpr size_t WS_S = WS_XC + (size_t)MT * 512 * 2;
constexpr size_t WS_MIX = WS_S + (size_t)256 * 4 * 64 * 128 * 4;
constexpr size_t WS_BAR = WS_MIX + (size_t)MT * D * 2;
constexpr size_t WS_XCT = WS_BAR + 16384;
constexpr size_t WS_END = WS_XCT + (size_t)NCI * 16384 * 2;
static_assert(WS_END <= (size_t)256 * 1024 * 1024, "workspace too large");
static_assert((size_t)MT * DFF * 2 <= (WS_S - WS_U), "hb alias");

struct Params {
    const float* x_prompt; const float* x_sample; const float* state_ssm; const float* state_ssm_conv;
    const float* cache_k; const float* cache_v; const float* state_sconv; const float* state_cconv;
    const float* norm_mix; const float* w_in; const float* ssm_conv_w; const float* ssm_conv_b;
    const float* ssm_dt_bias; const float* ssm_a_log; const float* ssm_d; const float* ssm_norm;
    const float* sinks; const float* sconv_w; const float* cconv_w; const float* cconv_b;
    const float* cconv_ln_g; const float* cconv_ln_b; const float* w_out; const float* norm_ffn;
    const float* w_gate; const float* w_up; const float* w_down; const float* norm_final;
    float* out; unsigned char* ws;
};

__device__ __forceinline__ unsigned pack_bf16(float lo, float hi) { unsigned r; asm("v_cvt_pk_bf16_f32 %0, %1, %2" : "=v"(r) : "v"(lo), "v"(hi)); return r; }
__device__ __forceinline__ bf16_t f2bf(float f) { return (bf16_t)(pack_bf16(f, 0.f) & 0xffffu); }
__device__ __forceinline__ float bf2f(bf16_t h) { return __uint_as_float(((unsigned)h) << 16); }
__device__ __forceinline__ float bflo(unsigned u) { return __uint_as_float(u << 16); }
__device__ __forceinline__ float bfhi(unsigned u) { return __uint_as_float(u & 0xffff0000u); }
__device__ __forceinline__ f32x4 mfma16(bf16x8 a, bf16x8 b, f32x4 c) { return __builtin_amdgcn_mfma_f32_16x16x32_bf16(a, b, c, 0, 0, 0); }
__device__ __forceinline__ int opaque(int x) { asm volatile("" : "+v"(x)); return x; }
__device__ __forceinline__ float sigmoidf_(float x) { return __builtin_amdgcn_rcpf(1.f + __expf(-x)); }
__device__ __forceinline__ float siluf_(float x) { return x * sigmoidf_(x); }
__device__ __forceinline__ float wave_sum(float v) {
#pragma unroll
    for (int o = 32; o >= 1; o >>= 1) v += __shfl_xor(v, o);
    return v;
}
template <int N> __device__ __forceinline__ float wave_sum_multi(float (&v)[N], int lane) {
    int n = N;
#pragma unroll
    for (int o = 32; o >= 1; o >>= 1) {
        if (n > 1) {
            const bool hi = (lane & o) != 0; const int hn = n / 2;
#pragma unroll
            for (int i = 0; i < hn; ++i) { const float send = hi ? v[i] : v[i + hn], keep = hi ? v[i + hn] : v[i]; v[i] = keep + __shfl_xor(send, o); }
            n = hn;
        } else v[0] += __shfl_xor(v[0], o);
    }
    return v[0];
}
__device__ __forceinline__ float rstd_row(const float* part, int row) {
    const f32x4* pr = (const f32x4*)(part + (size_t)row * 16);
    const f32x4 a = pr[0] + pr[1] + pr[2] + pr[3];
    const float ss = (a[0] + a[1]) + (a[2] + a[3]);
    return rsqrtf(ss * (1.f / 1024.f) + EPS);
}
__device__ __forceinline__ float rstd_row_q(const float* part, int row, int fq) {
    const f32x4 a = *(const f32x4*)(part + (size_t)row * 16 + fq * 4);
    float ss = (a[0] + a[1]) + (a[2] + a[3]);
    ss += __shfl_xor(ss, 16); ss += __shfl_xor(ss, 32);
    return rsqrtf(ss * (1.f / 1024.f) + EPS);
}
__device__ __forceinline__ u32x4 pack8(const float* v) { u32x4 r; r[0] = pack_bf16(v[0], v[1]); r[1] = pack_bf16(v[2], v[3]); r[2] = pack_bf16(v[4], v[5]); r[3] = pack_bf16(v[6], v[7]); return r; }
__device__ __forceinline__ u32x4 load8f_bf(const float* src) { const f32x4 a = *(const f32x4*)src, b = *(const f32x4*)(src + 4); u32x4 r; r[0] = pack_bf16(a[0], a[1]); r[1] = pack_bf16(a[2], a[3]); r[2] = pack_bf16(b[0], b[1]); r[3] = pack_bf16(b[2], b[3]); return r; }

struct Item { int r0, L, t0, b, c, s; bool samp; };
__device__ __forceinline__ Item decode_item(int ci) {
    Item it;
    if (ci < 256) { it.samp = false; it.b = ci >> 6; it.c = ci & 63; it.s = 0; it.r0 = ci * 64; it.L = 64; it.t0 = it.c * 64; }
    else { it.samp = true; it.s = ci - 256; it.b = 0; it.c = 0; it.r0 = MP + it.s * LS; it.L = LS; it.t0 = 0; }
    return it;
}

#define XB_TMO      128
#define XB_XCNT(j)  (256  + 64 * (j))
#define XB_XSUB(j)  (1280 + 64 * (j))
#define XB_XGEN(j)  (2304 + 64 * (j))
#define XB_TOP      3328
#define XB_TOPGEN   3392
#define XCD_BAR_WORDS 3456
#define XB_SPIN_CAP (1u << 18)
#define LAS __attribute__((address_space(3)))

__device__ __forceinline__ unsigned xb_ld(unsigned* p)              { return __hip_atomic_load(p, __ATOMIC_RELAXED, __HIP_MEMORY_SCOPE_AGENT); }
__device__ __forceinline__ unsigned xb_add(unsigned* p, unsigned v) { return __hip_atomic_fetch_add(p, v, __ATOMIC_RELAXED, __HIP_MEMORY_SCOPE_AGENT); }
__device__ __forceinline__ unsigned xb_xcc_id() { return (unsigned)__builtin_amdgcn_s_getreg((3 << 11) | 20) & 0xFu; }
#define XB_SPIN(cond, bar) do { unsigned _sp = 0; while (cond) { __builtin_amdgcn_s_sleep(1); \
    if ((++_sp & 255u) == 0u) { if (xb_ld(&(bar)[XB_TMO])) break; if (_sp > XB_SPIN_CAP) { atomicAdd(&(bar)[XB_TMO], 1u); break; } } } } while (0)

struct XcdBarrier {
    unsigned* bar; unsigned x;
    volatile LAS unsigned* st;
};

__device__ __forceinline__ XcdBarrier xcd_barrier_post(unsigned* bar, volatile LAS unsigned* st) {
    XcdBarrier b; b.bar = bar; b.x = xb_xcc_id(); b.st = st;
    if (threadIdx.x == 0) (void)xb_add(&bar[XB_XCNT(b.x)], 1u);
    return b;
}
__device__ __forceinline__ void xcd_barrier_complete(unsigned* bar, unsigned x, unsigned& nloc, unsigned& nx) {
    const unsigned G = gridDim.x * gridDim.y * gridDim.z;
    unsigned sum, cnt, mine, sp = 0u;
    for (;;) {
        sum = 0u; cnt = 0u; mine = 0u;
#pragma unroll
        for (unsigned j = 0; j < 16; ++j) { const unsigned c = xb_ld(&bar[XB_XCNT(j)]); sum += c; cnt += (c > 0u) ? 1u : 0u; mine = (j == x) ? c : mine; }
        if (sum == G) break;
        __builtin_amdgcn_s_sleep(1);
        if ((++sp & 255u) == 0u) { if (xb_ld(&bar[XB_TMO])) break; if (sp > XB_SPIN_CAP) { atomicAdd(&bar[XB_TMO], 1u); break; } }
    }
    nloc = mine > 0u ? mine : 1u; nx = cnt > 0u ? cnt : 1u;
}

__device__ __forceinline__ void xcd_barrier(const XcdBarrier& b) {
    asm volatile("s_waitcnt vmcnt(0)" ::: "memory");
    __syncthreads();
    if (threadIdx.x == 0) {
        unsigned* bar = b.bar;
        __builtin_amdgcn_s_waitcnt(0);
        unsigned nloc = b.st[0], nx = b.st[1];
        if (nloc == 0u) { xcd_barrier_complete(bar, b.x, nloc, nx); b.st[0] = nloc; b.st[1] = nx; }
        const unsigned old = xb_add(&bar[XB_XSUB(b.x)], 1u);
        const unsigned gen = old / nloc;
        if (old + 1u == (gen + 1u) * nloc) {
            __builtin_amdgcn_fence(__ATOMIC_RELEASE, "agent");
            asm volatile("s_waitcnt vmcnt(0)" ::: "memory");
            const unsigned og = xb_add(&bar[XB_TOP], 1u);
            const unsigned tg = og / nx;
            if (og + 1u == (tg + 1u) * nx) xb_add(&bar[XB_TOPGEN], 1u);
            else XB_SPIN(xb_ld(&bar[XB_TOPGEN]) == tg, bar);
            __builtin_amdgcn_fence(__ATOMIC_ACQUIRE, "agent");
            xb_add(&bar[XB_XGEN(b.x)], 1u);
            asm volatile("s_waitcnt vmcnt(0)" ::: "memory");
        } else {
            XB_SPIN(xb_ld(&bar[XB_XGEN(b.x)]) == gen, bar);
            __builtin_amdgcn_fence(__ATOMIC_ACQUIRE, "agent");
            asm volatile("s_waitcnt vmcnt(0)" ::: "memory");
        }
    }
    __syncthreads();
}

namespace pg8 {
#define PG8_LAS __attribute__((address_space(3)))
typedef unsigned short bf16_t;
typedef short bf16x8 __attribute__((ext_vector_type(8)));
typedef float f32x4 __attribute__((ext_vector_type(4)));
typedef unsigned u32x4 __attribute__((ext_vector_type(4)));
constexpr int BM = 256, BK = 64, HALF = 128, HTB = HALF * BK * 2  , STAGE_BYTES = 8 * HTB, NXCD = 8, WGM = 4;

__host__ __device__ __forceinline__ int lds_byte(int r, int c) { const int st = (r >> 4) * 2 + (c >> 5), rr = r & 15, cc = c & 31, ob = rr * 64 + cc * 2; return st * 1024 + (ob ^ (((ob >> 9) & 1) << 5)); }
__host__ __device__ __forceinline__ void stage_rc(int b, int& R, int& C) { const int st = b / 1024, sb = b % 1024, swz = sb ^ (((sb >> 9) & 1) << 5); R = (st >> 1) * 16 + swz / 64; C = (st & 1) * 32 + (swz % 64) / 2; }
__host__ __device__ __forceinline__ int perm32(int rho) { const int n = rho >> 4, i = rho & 15; return 8 * (i >> 2) + 4 * n + (i & 3); }

struct Unit { int pm, pn; };
struct Gemm { const bf16_t* A; const bf16_t* Bt; int M, N, K; };

struct StaticOrder {
    int nM, nN, nwg, G, c;
    __host__ __device__ void init(int M, int N, int G_, int c_) { nM = M / BM; nN = N / BM; nwg = nM * nN; G = G_; c = c_; }
    __host__ __device__ bool next(int i, Unit& u) const {
        const long L = (long)i * G + c; if (L >= nwg) return false;
        int wgid = (int)L; { const int q = nwg / NXCD, r = nwg % NXCD, xcd = wgid % NXCD, off = wgid / NXCD; wgid = (xcd < r ? xcd * (q + 1) : r * (q + 1) + (xcd - r) * q) + off; }
        const int nig = WGM * nN, gid = wgid / nig, fm = gid * WGM, gsz = (nM - fm) < WGM ? (nM - fm) : WGM;
        u.pm = fm + ((wgid % nig) % gsz); u.pn = (wgid % nig) / gsz; return true;
    }
    __device__ __forceinline__ void a_ready(const Unit&) const {}
    __device__ __forceinline__ void done(const Unit&) const {}
};
template <class Epi, class Sched, bool STAMP = false>
__device__ __forceinline__ void gemm_phase(PG8_LAS unsigned char* lds, const Gemm g, const Sched& S, const Epi& E, unsigned long long* stamps) {
    const int tid = opaque(threadIdx.x), wid = __builtin_amdgcn_readfirstlane(tid >> 6), lane = tid & 63, wr = wid >> 2, wc = wid & 3, fr = lane & 15, fq = lane >> 4;
    const int K = g.K, nt = K / BK;
    int ts_lo = 0, ts_hi = 0, nts = 0; const unsigned long long rt_entry = STAMP ? (unsigned long long)wall_clock64() : 0ull;
#define PG8_STAMP() do { if (STAMP && wid == 0 && nts < 64) { const unsigned long long _c = (unsigned long long)clock64(); \
        ts_lo = (lane == nts) ? (int)(unsigned)_c : ts_lo; ts_hi = (lane == nts) ? (int)(unsigned)(_c >> 32) : ts_hi; ++nts; } } while (0)
    PG8_STAMP();
    unsigned voffA[2], voffB[2];
#pragma unroll
    for (int i = 0; i < 2; ++i) { int R, C; stage_rc(tid * 16 + i * 8192, R, C); const int Rb = Epi::PERM ? ((R & ~31) + perm32(R & 31)) : R;
        voffA[i] = (unsigned)(R * K + C) * 2u; voffB[i] = (unsigned)(Rb * K + C) * 2u; }
    const size_t kstep = (size_t)(BK * 2);
    const size_t hstep = (size_t)HALF * K * 2;
    const size_t tstep = 2 * hstep;
    const unsigned ldsw = (unsigned)wid * 1024u;
    const int aoff = lds_byte(wr * 64 + fr, fq * 8), boff = lds_byte(wc * 32 + fr, fq * 8);
#define PG8_SA(b, h) (((b) * 2 + (h)) * HTB)
#define PG8_SB(b, h) ((4 + (b) * 2 + (h)) * HTB)
#define PG8_STAGE(bufoff, gbase, voff) do { _Pragma("unroll") for (int _i = 0; _i < 2; ++_i) \
        __builtin_amdgcn_global_load_lds((const unsigned*)((const char*)(gbase) + (voff)[_i]), (PG8_LAS unsigned*)(lds + (bufoff) + ldsw + _i * 8192), 16, 0, 0); } while (0)
#define PG8_LDA(dst, b, h) do { _Pragma("unroll") for (int m = 0; m < 4; ++m) _Pragma("unroll") for (int k = 0; k < 2; ++k) dst[m][k] = *(const PG8_LAS bf16x8*)(lds + PG8_SA(b, h) + aoff + m * 2048 + k * 1024); } while (0)
#define PG8_LDB(dst, b, h) do { _Pragma("unroll") for (int n = 0; n < 2; ++n) _Pragma("unroll") for (int k = 0; k < 2; ++k) dst[n][k] = *(const PG8_LAS bf16x8*)(lds + PG8_SB(b, h) + boff + n * 2048 + k * 1024); } while (0)
#define PG8_MMA(ai, bj, At, Bt) do { __builtin_amdgcn_s_setprio(1); _Pragma("unroll") for (int m = 0; m < 4; ++m) _Pragma("unroll") for (int n = 0; n < 2; ++n) _Pragma("unroll") for (int k = 0; k < 2; ++k) \
        acc[ai][bj][m][n] = __builtin_amdgcn_mfma_f32_16x16x32_bf16(Bt[n][k], At[m][k], acc[ai][bj][m][n], 0, 0, 0); __builtin_amdgcn_s_setprio(0); } while (0)
#define PG8_WAIT_V(n) asm volatile("s_waitcnt vmcnt(" #n ")" ::: "memory")
#define PG8_WAIT_L(n) asm volatile("s_waitcnt lgkmcnt(" #n ")" ::: "memory")
#define PG8_BAR __builtin_amdgcn_s_barrier()
#define PG8_SCHED __builtin_amdgcn_sched_barrier(0)
    Unit cur, nxt; int ui = 0;
    if (!S.next(0, cur)) return;
    f32x4 acc[2][2][4][2];
#pragma unroll
    for (int a = 0; a < 2; ++a)
#pragma unroll
        for (int b = 0; b < 2; ++b)
#pragma unroll
            for (int m = 0; m < 4; ++m)
#pragma unroll
                for (int n = 0; n < 2; ++n) acc[a][b][m][n] = (f32x4){0.f, 0.f, 0.f, 0.f};
    bf16x8 At[4][2], B0[2][2], B1[2][2];
    const char* cA = (const char*)g.A + (size_t)cur.pm * tstep; const char* cB = (const char*)g.Bt + (size_t)cur.pn * tstep;
    S.a_ready(cur);
    PG8_STAGE(PG8_SB(0, 0), cB, voffB); PG8_STAGE(PG8_SA(0, 0), cA, voffA); PG8_STAGE(PG8_SB(0, 1), cB + hstep, voffB); PG8_STAGE(PG8_SA(0, 1), cA + hstep, voffA);
    if (wr == 1) PG8_BAR;
    PG8_WAIT_V(4); PG8_BAR;
    PG8_STAGE(PG8_SB(1, 0), cB + kstep, voffB); PG8_STAGE(PG8_SA(1, 0), cA + kstep, voffA); PG8_STAGE(PG8_SB(1, 1), cB + hstep + kstep, voffB);
    PG8_WAIT_V(6); PG8_BAR;
    PG8_STAMP();
    for (;;) {
        const bool has_next = S.next(ui + 1, nxt);
        const char* nA = has_next ? (const char*)g.A + (size_t)nxt.pm * tstep : cA; const char* nB = has_next ? (const char*)g.Bt + (size_t)nxt.pn * tstep : cB;
        for (int t = 0; t < nt; t += 2) {
            const bool last = (t == nt - 2);
            const char* a1 = cA + (size_t)(t + 1) * kstep;
            const char* a2 = last ? nA : cA + (size_t)(t + 2) * kstep; const char* b2 = last ? nB : cB + (size_t)(t + 2) * kstep;
            const char* a3 = a2 + kstep; const char* b3 = b2 + kstep;
            if (last && has_next) S.a_ready(nxt);
            PG8_LDB(B0, 0, 0); PG8_SCHED; PG8_LDA(At, 0, 0); PG8_STAGE(PG8_SA(1, 1), a1 + hstep, voffA);
            PG8_WAIT_L(8); PG8_BAR; PG8_WAIT_L(0); PG8_MMA(0, 0, At, B0); PG8_BAR; PG8_SCHED;
            PG8_LDB(B1, 0, 1); PG8_STAGE(PG8_SB(0, 0), b2, voffB);
            PG8_BAR; PG8_WAIT_L(0); PG8_MMA(0, 1, At, B1); PG8_BAR;
            PG8_LDA(At, 0, 1); PG8_STAGE(PG8_SA(0, 0), a2, voffA);
            PG8_BAR; PG8_WAIT_L(0); PG8_MMA(1, 0, At, B0); PG8_BAR; PG8_SCHED;
            PG8_STAGE(PG8_SB(0, 1), b2 + hstep, voffB);
            PG8_WAIT_V(6); PG8_BAR; PG8_MMA(1, 1, At, B1); PG8_BAR;
            PG8_LDB(B0, 1, 0); PG8_SCHED; PG8_LDA(At, 1, 0); PG8_STAGE(PG8_SA(0, 1), a2 + hstep, voffA);
            PG8_WAIT_L(8); PG8_BAR; PG8_WAIT_L(0); PG8_MMA(0, 0, At, B0); PG8_BAR; PG8_SCHED;
            PG8_LDB(B1, 1, 1); PG8_STAGE(PG8_SB(1, 0), b3, voffB);
            PG8_BAR; PG8_WAIT_L(0); PG8_MMA(0, 1, At, B1); PG8_BAR;
            PG8_LDA(At, 1, 1); PG8_STAGE(PG8_SA(1, 0), a3, voffA);
            PG8_BAR; PG8_WAIT_L(0); PG8_MMA(1, 0, At, B0); PG8_BAR; PG8_SCHED;
            PG8_STAGE(PG8_SB(1, 1), b3 + hstep, voffB);
            PG8_WAIT_V(6); PG8_BAR; PG8_MMA(1, 1, At, B1); PG8_BAR;
        }
        PG8_STAMP();
        if constexpr (!Epi::AFTER_DRAIN) { E(acc, cur, ui, wr, wc, fr, fq); S.done(cur); }
        PG8_STAMP();
        if (!has_next) break;
#pragma unroll
        for (int a = 0; a < 2; ++a)
#pragma unroll
            for (int b = 0; b < 2; ++b)
#pragma unroll
                for (int m = 0; m < 4; ++m)
#pragma unroll
                    for (int n = 0; n < 2; ++n) acc[a][b][m][n] = (f32x4){0.f, 0.f, 0.f, 0.f};
        cur = nxt; cA = nA; cB = nB; ++ui;
    }
    PG8_WAIT_V(0);
    if (wr == 0) PG8_BAR;
    PG8_BAR;
    if constexpr (Epi::AFTER_DRAIN) { E.fused(acc, cur, wr, wc, fr, fq, lds, wid, lane); S.done(cur); }
    PG8_STAMP();
    if (STAMP && wid == 0) { stamps[lane] = lane < nts ? (((unsigned long long)(unsigned)ts_hi << 32) | (unsigned)ts_lo) : 0ull;
        if (lane == 62) stamps[62] = rt_entry; if (lane == 63) stamps[63] = (unsigned long long)wall_clock64(); }
#undef PG8_STAMP
#undef PG8_SA
#undef PG8_SB
#undef PG8_STAGE
#undef PG8_LDA
#undef PG8_LDB
#undef PG8_MMA
#undef PG8_WAIT_V
#undef PG8_WAIT_L
#undef PG8_BAR
#undef PG8_SCHED
}
}

struct EpiU {
    static constexpr bool PERM = true, AFTER_DRAIN = false;
    bf16_t* u; const float* rtab;
    __device__ __forceinline__ void operator()(const f32x4 (&acc)[2][2][4][2], const pg8::Unit& un, int ui, int wr, int wc, int fr, int fq) const {
        if (un.pn < 6) {
#pragma unroll
            for (int ai = 0; ai < 2; ++ai)
#pragma unroll
                for (int m = 0; m < 4; ++m) {
                    const int row = un.pm * 256 + ai * 128 + wr * 64 + m * 16 + fr; const float rs = rtab[ui * 256 + ai * 128 + wr * 64 + m * 16 + fr];
                    bf16_t* dst = u + (size_t)row * NU + un.pn * 256 + wc * 32 + fq * 8;
#pragma unroll
                    for (int bj = 0; bj < 2; ++bj) {
                        const f32x4 a = acc[ai][bj][m][0], b = acc[ai][bj][m][1]; u32x4 v;
                        v[0] = pack_bf16(a[0] * rs, a[1] * rs); v[1] = pack_bf16(a[2] * rs, a[3] * rs); v[2] = pack_bf16(b[0] * rs, b[1] * rs); v[3] = pack_bf16(b[2] * rs, b[3] * rs);
                        *(u32x4*)(dst + bj * 128) = v;
                    }
                }
        } else {
            const int t = un.pn - 6; const bool glu = t >= 2;
            const int cbase = (glu ? 1792 + 128 * (t - 2) : 1536 + 128 * t) + wc * 32 + fq * 8;
#pragma unroll
            for (int ai = 0; ai < 2; ++ai)
#pragma unroll
                for (int m = 0; m < 4; ++m) {
                    const int row = un.pm * 256 + ai * 128 + wr * 64 + m * 16 + fr; const float rs = rtab[ui * 256 + ai * 128 + wr * 64 + m * 16 + fr];
                    float x8[8], y8[8];
#pragma unroll
                    for (int q = 0; q < 8; ++q) { x8[q] = acc[ai][q >> 2][m][0][q & 3] * rs; y8[q] = acc[ai][q >> 2][m][1][q & 3] * rs; }
                    if (glu) {
#pragma unroll
                        for (int q = 0; q < 8; ++q) y8[q] = __builtin_amdgcn_exp2f(y8[q] * -1.4426950408889634f);
#pragma unroll
                        for (int q = 0; q < 8; ++q) y8[q] = __builtin_amdgcn_rcpf(1.f + y8[q]);
                    }
#pragma unroll
                    for (int q = 0; q < 8; ++q) x8[q] *= y8[q];
                    *(u32x4*)(u + (size_t)row * NU + cbase) = pack8(x8);
                }
        }
    }
};
struct EpiRes {
    static constexpr bool PERM = true, AFTER_DRAIN = false;
    bf16_t* xb; float* part;
    __device__ __forceinline__ void operator()(const f32x4 (&acc)[2][2][4][2], const pg8::Unit& un, int ui, int wr, int wc, int fr, int fq) const {
        bf16_t* x0 = xb + (size_t)(un.pm * 256 + wr * 64 + fr) * D + un.pn * 256 + wc * 32 + fq * 8;
        u32x4 old[2][4][2];
#pragma unroll
        for (int ai = 0; ai < 2; ++ai)
#pragma unroll
            for (int m = 0; m < 4; ++m)
#pragma unroll
                for (int bj = 0; bj < 2; ++bj) old[ai][m][bj] = *(const u32x4*)(x0 + (size_t)(ai * 128 + m * 16) * D + bj * 128);
#pragma unroll
        for (int ai = 0; ai < 2; ++ai)
#pragma unroll
            for (int m = 0; m < 4; ++m) {
                const int row = un.pm * 256 + ai * 128 + wr * 64 + m * 16 + fr; float ss = 0.f;
                bf16_t* xr = x0 + (size_t)(ai * 128 + m * 16) * D;
#pragma unroll
                for (int bj = 0; bj < 2; ++bj) {
                    float v[8];
#pragma unroll
                    for (int q = 0; q < 4; ++q) { v[2 * q] = bflo(old[ai][m][bj][q]) + acc[ai][bj][m][q >> 1][(2 * q) & 3]; v[2 * q + 1] = bfhi(old[ai][m][bj][q]) + acc[ai][bj][m][q >> 1][(2 * q + 1) & 3]; }
#pragma unroll
                    for (int q = 0; q < 8; ++q) ss += v[q] * v[q];
                    *(u32x4*)(xr + bj * 128) = pack8(v);
                }
                ss += __shfl_xor(ss, 16); ss += __shfl_xor(ss, 32);
                if (fq == 0) part[(size_t)row * 16 + un.pn * 4 + wc] = ss;
            }
    }
};
struct EpiGlu {
    static constexpr bool PERM = false, AFTER_DRAIN = false;
    bf16_t* hb; const float* rtab;
    __device__ __forceinline__ void operator()(const f32x4 (&acc)[2][2][4][2], const pg8::Unit& un, int ui, int wr, int wc, int fr, int fq) const {
#pragma unroll
        for (int ai = 0; ai < 2; ++ai)
#pragma unroll
            for (int m = 0; m < 4; ++m) {
                const int row = un.pm * 256 + ai * 128 + wr * 64 + m * 16 + fr; const float rs = rtab[ui * 256 + ai * 128 + wr * 64 + m * 16 + fr];
                const float nrs = rs * -1.4426950408889634f, rs2 = rs * rs;
                typedef float f32x2_ __attribute__((ext_vector_type(2)));
                float h[8]; f32x2_ t2[4], h2[4];
#pragma unroll
                for (int q = 0; q < 4; ++q) {
                    const f32x2_ g2 = {acc[ai][q >> 1][m][0][(2 * q) & 3], acc[ai][q >> 1][m][0][(2 * q + 1) & 3]}, u2 = {acc[ai][q >> 1][m][1][(2 * q) & 3], acc[ai][q >> 1][m][1][(2 * q + 1) & 3]};
                    const f32x2_ a2 = g2 * nrs; t2[q][0] = __builtin_amdgcn_exp2f(a2[0]); t2[q][1] = __builtin_amdgcn_exp2f(a2[1]);
                    h2[q] = (g2 * u2) * rs2;
                }
#pragma unroll
                for (int q = 0; q < 4; ++q) { const f32x2_ d2 = t2[q] + 1.f; t2[q][0] = __builtin_amdgcn_rcpf(d2[0]); t2[q][1] = __builtin_amdgcn_rcpf(d2[1]); }
#pragma unroll
                for (int q = 0; q < 4; ++q) { const f32x2_ r2 = h2[q] * t2[q]; h[2 * q] = r2[0]; h[2 * q + 1] = r2[1]; }
                *(u32x4*)(hb + (size_t)row * DFF + un.pn * 128 + wc * 32 + fq * 8) = pack8(h);
            }
    }
};
__device__ __forceinline__ float* build_rstd_table(const float* part, int M, int N, unsigned char* smem) {
    const int tid = opaque(threadIdx.x);
    float* rtab = (float*)(smem + LDS_BYTES + 64);
    pg8::StaticOrder S; S.init(M, N, (int)gridDim.x, (int)blockIdx.x);
    pg8::Unit un;
    for (int i = 0; i < 16 && S.next(i, un); ++i) if (tid < 256) rtab[i * 256 + tid] = rstd_row(part, un.pm * 256 + tid);
    __syncthreads();
    return rtab;
}
template <class Epi>
__device__ __forceinline__ void run_gemm(const bf16_t* A, const bf16_t* Bt, int M, int N, int K, const Epi& e, unsigned char* smem) {
    pg8::Gemm g{A, Bt, M, N, K};
    pg8::StaticOrder S; S.init(M, N, (int)gridDim.x, (int)blockIdx.x);
    pg8::gemm_phase<Epi, pg8::StaticOrder, false>((PG8_LAS unsigned char*)smem, g, S, e, nullptr);
}

__device__ __forceinline__ void gemm_small_res(const bf16_t* A, const bf16_t* Bt, int K, bf16_t* xb, float* part, unsigned char* smem) {
    const int tid = opaque(threadIdx.x), lane = tid & 63, w = tid >> 6, fr = lane & 15, fq = lane >> 4;
    float* red = (float*)smem;
    float* ssb = (float*)(smem + 65536);
    const int kw = K / 8;
    for (int tile = blockIdx.x; tile < 256; tile += gridDim.x) {
        const int row0 = MP + (tile >> 4) * 32, col0 = (tile & 15) * 64;
        f32x4 acc[2][4];
#pragma unroll
        for (int i = 0; i < 2; ++i)
#pragma unroll
            for (int j = 0; j < 4; ++j) acc[i][j] = (f32x4){0.f, 0.f, 0.f, 0.f};
        const bf16_t* ap = A + (size_t)(row0 + fr) * K + w * kw + fq * 8;
        const bf16_t* bp = Bt + (size_t)(col0 + fr) * K + w * kw + fq * 8;
        const int mt = w >> 2, nt = w & 3, rl = mt * 16 + fr;
        const size_t o = (size_t)(row0 + rl) * D + col0 + nt * 16 + fq * 4;
        const u32x2 ob = *(const u32x2*)(xb + o);
#pragma unroll 6
        for (int k = 0; k < kw; k += 32) {
            bf16x8 af[2], bfv[4];
#pragma unroll
            for (int i = 0; i < 2; ++i) af[i] = *(const bf16x8*)(ap + (size_t)i * 16 * K + k);
#pragma unroll
            for (int j = 0; j < 4; ++j) bfv[j] = *(const bf16x8*)(bp + (size_t)j * 16 * K + k);
#pragma unroll
            for (int i = 0; i < 2; ++i)
#pragma unroll
                for (int j = 0; j < 4; ++j) acc[i][j] = mfma16(bfv[j], af[i], acc[i][j]);
        }
        __syncthreads();
#pragma unroll
        for (int i = 0; i < 2; ++i)
#pragma unroll
            for (int j = 0; j < 4; ++j) *(f32x4*)(red + (size_t)(((w * 8 + i * 4 + j) * 64 + lane) * 4)) = acc[i][j];
        __syncthreads();
        f32x4 sum = (f32x4){0.f, 0.f, 0.f, 0.f};
#pragma unroll
        for (int ww = 0; ww < 8; ++ww) sum += *(const f32x4*)(red + (size_t)(((ww * 8 + w) * 64 + lane) * 4));
        f32x4 v; v[0] = bflo(ob[0]) + sum[0]; v[1] = bfhi(ob[0]) + sum[1]; v[2] = bflo(ob[1]) + sum[2]; v[3] = bfhi(ob[1]) + sum[3];
        u32x2 pk; pk[0] = pack_bf16(v[0], v[1]); pk[1] = pack_bf16(v[2], v[3]); *(u32x2*)(xb + o) = pk;
        ssb[rl * 16 + nt * 4 + fq] = v[0] * v[0] + v[1] * v[1] + v[2] * v[2] + v[3] * v[3];
        __syncthreads();
        if (tid < 32) {
            const f32x4* sp = (const f32x4*)(ssb + tid * 16); const f32x4 a = sp[0] + sp[1] + sp[2] + sp[3];
            part[(size_t)(row0 + tid) * 16 + (tile & 15)] = (a[0] + a[1]) + (a[2] + a[3]);
        }
    }
    __syncthreads();
}

struct PrepT { int l, kind, n0, k0, K; };
__device__ __forceinline__ PrepT prep_decode(int it) {
    PrepT t; t.l = it / 753; int r = it % 753;
    if (r == 752) { t.kind = 4; t.n0 = 0; t.k0 = 0; t.K = 0; return t; }
    int tn, tk;
    if (r < 160) { t.kind = 0; tn = r >> 2; tk = r & 3; t.K = 1024; }
    else if (r < 224) { r -= 160; t.kind = 1; tn = r >> 2; tk = r & 3; t.K = 1024; }
    else if (r < 576) { r -= 224; t.kind = 2; tn = r >> 2; tk = r & 3; t.K = 1024; }
    else { r -= 576; t.kind = 3; tn = r / 11; tk = r % 11; t.K = DFF; }
    t.n0 = tn * 64; t.k0 = tk * 256; return t;
}
struct V8 { f32x4 a[8]; };
__device__ __forceinline__ V8 prep_load(const Params& p, const PrepT& t, int tid) {
    V8 r;
#pragma unroll
    for (int i = 0; i < 8; ++i) r.a[i] = (f32x4){0.f, 0.f, 0.f, 0.f};
    if (t.kind == 4) return r;
    const int l = t.l, nn = (tid & 15) * 4, n = t.n0 + nn, kb = tid >> 4;
    const float* src; size_t ld;
    if (t.kind == 0) {
        int col;
        if (n < 1536) col = n < 768 ? n : n + 4;
        else {
            const int tt = (n - 1536) >> 8, c = n & 255, o = ((c >> 5) & 3) * 32 + ((c >> 3) & 3) * 8 + ((c >> 7) & 1) * 4, second = (c >> 2) & 1;
            col = (tt < 2 ? (second ? 1792 : 1536) + 128 * tt : (second ? 2304 : 2048) + 128 * (tt - 2)) + o + 4;
        }
        src = p.w_in + (size_t)l * D * DIN + col; ld = DIN;
    }
    else if (t.kind == 1) { src = p.w_out + (size_t)l * D * D + n; ld = D; }
    else if (t.kind == 2) { src = (((n >> 4) & 1) ? p.w_up : p.w_gate) + (size_t)l * D * DFF + (n >> 8) * 128 + ((n >> 5) & 3) * 32 + ((n >> 2) & 3) * 8 + ((n >> 7) & 1) * 4; ld = DFF; }
    else { src = p.w_down + (size_t)l * DFF * D + n; ld = D; }
#pragma unroll
    for (int i = 0; i < 8; ++i) r.a[i] = *(const f32x4*)(src + (size_t)(t.k0 + kb + 32 * i) * ld);
    return r;
}
__device__ __forceinline__ void prep_finish(const Params& p, const PrepT& t, int tid, const V8 vv, unsigned char* smem) {
    const int l = t.l;
    if (t.kind == 4) {
        float* wdt = (float*)(p.ws + WS_WDT) + (size_t)l * 4096;
        for (int e = tid; e < 4096; e += NTHR) { const int h = e >> 10, k = e & 1023; wdt[e] = p.norm_mix[l * D + k] * p.w_in[((size_t)l * D + k) * DIN + 768 + h]; }
        return;
    }
    float* tile = (float*)smem;
    __syncthreads();
    {
        const int nn = (tid & 15) * 4, kb = tid >> 4;
        const float* gain = t.kind == 0 ? p.norm_mix + l * D : (t.kind == 2 ? p.norm_ffn + l * D : nullptr);
#pragma unroll
        for (int i = 0; i < 8; ++i) {
            const int kk = kb + 32 * i; const float gsc = gain ? gain[t.k0 + kk] : 1.f;
#pragma unroll
            for (int e = 0; e < 4; ++e) tile[(nn + e) * 257 + kk] = vv.a[i][e] * gsc;
        }
    }
    __syncthreads();
    bf16_t* dst = (bf16_t*)(p.ws + (t.kind == 0 ? WS_WIN + l * W_IN_B : t.kind == 1 ? WS_WOUT + l * W_OUT_B : t.kind == 2 ? WS_WGU + l * W_GU_B : WS_WDN + l * W_DN_B));
#pragma unroll 4
    for (int i = 0; i < 16; ++i) {
        const int idx = tid + NTHR * i, nn = idx >> 7, kp = idx & 127;
        *(unsigned*)(dst + (size_t)(t.n0 + nn) * t.K + t.k0 + 2 * kp) = pack_bf16(tile[nn * 257 + 2 * kp], tile[nn * 257 + 2 * kp + 1]);
    }
}
struct Row4 { f32x4 a[4]; };
__device__ __forceinline__ Row4 init_rows_load(const Params& p, int it, int tid) {
    const int lane = tid & 63, w = tid >> 6, row = it * 8 + w;
    const float* src = row < MP ? p.x_prompt + (size_t)row * D : p.x_sample + (size_t)(row - MP) * D;
    Row4 r;
#pragma unroll
    for (int i = 0; i < 4; ++i) r.a[i] = *(const f32x4*)(src + i * 256 + lane * 4);
    return r;
}
__device__ __forceinline__ void init_rows_finish(const Params& p, int it, int tid, const Row4 r) {
    const int lane = tid & 63, w = tid >> 6, row = it * 8 + w;
    bf16_t* xb = (bf16_t*)(p.ws + WS_XB) + (size_t)row * D;
    float ss = 0.f;
#pragma unroll
    for (int i = 0; i < 4; ++i) {
        const int c = i * 256 + lane * 4; const f32x4 v = r.a[i];
        u32x2 pk; pk[0] = pack_bf16(v[0], v[1]); pk[1] = pack_bf16(v[2], v[3]); *(u32x2*)(xb + c) = pk;
        ss += v[0] * v[0] + v[1] * v[1] + v[2] * v[2] + v[3] * v[3];
    }
    ss = wave_sum(ss);
    if (lane < 16) ((float*)(p.ws + WS_PART))[(size_t)row * 16 + lane] = lane == 0 ? ss : 0.f;
}
__device__ __forceinline__ void prep_in_idle_slots(const Params& p, int nwg, int a_lo, int a_hi, int b_lo, int b_hi, int c_item, unsigned char* smem) {
    const int tid = opaque(threadIdx.x);
    const int G = (int)gridDim.x, rounds = (nwg + G - 1) / G;
    int first_idle = nwg - (rounds - 1) * G, nidle = G - first_idle;
    if (nidle <= 0) { first_idle = 0; nidle = G; }
    const int j = (int)blockIdx.x - first_idle;
    if (j < 0) return;
    const int na = a_hi - a_lo, nb = b_hi - b_lo, ntot = na + nb + (c_item >= 0 ? 1 : 0);
    for (int v = j; v < ntot; v += nidle) {
        const int it = v < na ? a_lo + v : (v < na + nb ? b_lo + (v - na) : c_item);
        const PrepT t = prep_decode(it);
        const V8 vv = prep_load(p, t, tid);
        prep_finish(p, t, tid, vv, smem);
    }
    __syncthreads();
}

__device__ __forceinline__ void swa_item(const Params& p, int l, int ci, int kvh, unsigned char* smem) {
    const int tid = opaque(threadIdx.x), lane = tid & 63, w = tid >> 6, fr = lane & 15, fq = lane >> 4;
    const Item it = decode_item(ci);
    bf16_t* Ks = (bf16_t*)smem;
    bf16_t* Vt = (bf16_t*)(smem + 27648);
    bf16_t* Ps = (bf16_t*)(smem + 27648 + 25600);
    float* invs = (float*)(smem + 27648 + 25600 + 51200);
    const bf16_t* u = (const bf16_t*)(p.ws + WS_U);
    bf16_t* mix = (bf16_t*)(p.ws + WS_MIX);
    const int kbase = it.samp ? (PAST - 128) : (it.t0 - 128);
    const int qbase = it.samp ? PAST : it.t0;
    const int nkeys = it.samp ? 144 : 192;
    bf16_t* Vr = Ps;
    const float sink = p.sinks[l * 4 + kvh * 2 + (tid >> 8)];
    bf16x8 qf[2];
    {
        const int qt_ = (tid >> 6) & 3, h_ = kvh * 2 + (tid >> 8);
        const int qrow = it.r0 + ((qt_ * 16 < it.L) ? qt_ * 16 + fr : fr);
        const bf16_t* qsrc = u + (size_t)qrow * NU + 768 + h_ * 64 + fq * 8;
        qf[0] = *(const bf16x8*)qsrc; qf[1] = *(const bf16x8*)(qsrc + 32);
    }
    {
        u32x4 kvr[3], vvr[3];
#pragma unroll
        for (int i = 0; i < 3; ++i) {
            const int idx = tid + NTHR * i, key = idx >> 3, part = idx & 7;
            u32x4 kv = (u32x4){0u, 0u, 0u, 0u}, vv = (u32x4){0u, 0u, 0u, 0u};
            if (!it.samp) {
                const int tg = it.t0 - 128 + key;
                if (tg >= 0) { const bf16_t* src = u + (size_t)(it.b * SEQ + tg) * NU + kvh * 64 + part * 8; kv = *(const u32x4*)(src + 1024); vv = *(const u32x4*)(src + 1152); }
            } else if (key < 128) {
                const size_t o = ((((size_t)l * NS + it.s) * 128 + key) * 2 + kvh) * 64 + part * 8;
                kv = load8f_bf(p.cache_k + o); vv = load8f_bf(p.cache_v + o);
            } else if (key < 144) {
                const bf16_t* src = u + (size_t)(MP + it.s * LS + key - 128) * NU + kvh * 64 + part * 8; kv = *(const u32x4*)(src + 1024); vv = *(const u32x4*)(src + 1152);
            }
            kvr[i] = kv; vvr[i] = vv;
        }
#pragma unroll
        for (int i = 0; i < 3; ++i) {
            const int idx = tid + NTHR * i, key = idx >> 3, part = idx & 7;
            *(u32x4*)(Ks + key * 72 + part * 8) = kvr[i]; *(u32x4*)(Vr + key * 72 + part * 8) = vvr[i];
        }
    }
    __syncthreads();
#pragma unroll
    for (int i = 0; i < 3; ++i) {
        const int idx = tid + NTHR * i, d = idx & 63, kg = idx >> 6;
        float dummy; (void)dummy;
        unsigned short e[8];
#pragma unroll
        for (int j = 0; j < 8; ++j) e[j] = Vr[(kg * 8 + j) * 72 + d];
        u32x4 o; o[0] = e[0] | ((unsigned)e[1] << 16); o[1] = e[2] | ((unsigned)e[3] << 16); o[2] = e[4] | ((unsigned)e[5] << 16); o[3] = e[6] | ((unsigned)e[7] << 16);
        *(u32x4*)(Vt + d * 200 + kg * 8) = o;
    }
    __syncthreads();
    const int g = w >> 2, qt = w & 3, h = kvh * 2 + g;
    const bool active = qt * 16 < it.L;
    if (active) {
        f32x4 sacc[12];
#pragma unroll
        for (int kt = 0; kt < 12; ++kt) sacc[kt] = (f32x4){0.f, 0.f, 0.f, 0.f};
#pragma unroll
        for (int kt = 0; kt < 12; ++kt)
#pragma unroll
            for (int ks = 0; ks < 2; ++ks) { const bf16x8 kf = *(const bf16x8*)(Ks + (kt * 16 + fr) * 72 + ks * 32 + fq * 8); sacc[kt] = mfma16(kf, qf[ks], sacc[kt]); }
        const float slope = exp2f(-2.f * (float)(h + 1));
        const int qpos = qbase + qt * 16 + fr;
        float m = sink;
#pragma unroll
        for (int kt = 0; kt < 12; ++kt)
#pragma unroll
            for (int r = 0; r < 4; ++r) {
                const int key = kt * 16 + fq * 4 + r, kpos = kbase + key;
                const bool valid = (kpos >= 0) && (key < nkeys);
                float sv = sacc[kt][r] * 0.125f - slope * fabsf((float)(qpos - kpos));
                sv = valid ? sv : -INFINITY; sacc[kt][r] = sv; m = fmaxf(m, sv);
            }
        m = fmaxf(m, __shfl_xor(m, 16)); m = fmaxf(m, __shfl_xor(m, 32));
        float sum = 0.f;
#pragma unroll
        for (int kt = 0; kt < 12; ++kt)
#pragma unroll
            for (int r = 0; r < 4; ++r) { const float pv = __expf(sacc[kt][r] - m); sacc[kt][r] = pv; sum += pv; }
        sum += __shfl_xor(sum, 16); sum += __shfl_xor(sum, 32);
        sum += __expf(sink - m);
        bf16_t* prow = Ps + (g * 64 + qt * 16 + fr) * 200 + fq * 4;
#pragma unroll
        for (int kt = 0; kt < 12; ++kt) { u32x2 pk; pk[0] = pack_bf16(sacc[kt][0], sacc[kt][1]); pk[1] = pack_bf16(sacc[kt][2], sacc[kt][3]); *(u32x2*)(prow + kt * 16) = pk; }
        if (fq == 0) invs[w * 16 + fr] = 1.f / sum;
    }
    __syncthreads();
    if (active) {
        f32x4 o[4];
#pragma unroll
        for (int dt = 0; dt < 4; ++dt) o[dt] = (f32x4){0.f, 0.f, 0.f, 0.f};
#pragma unroll
        for (int ks = 0; ks < 6; ++ks) {
            const bf16x8 pf = *(const bf16x8*)(Ps + (g * 64 + qt * 16 + fr) * 200 + ks * 32 + fq * 8);
#pragma unroll
            for (int dt = 0; dt < 4; ++dt) { const bf16x8 vf = *(const bf16x8*)(Vt + (dt * 16 + fr) * 200 + ks * 32 + fq * 8); o[dt] = mfma16(pf, vf, o[dt]); }
        }
#pragma unroll
        for (int r = 0; r < 4; ++r) {
            const int q = qt * 16 + fq * 4 + r; const float iv = invs[w * 16 + fq * 4 + r];
            bf16_t* dst = mix + (size_t)(it.r0 + q) * D + 256 + h * 64 + fr;
#pragma unroll
            for (int dt = 0; dt < 4; ++dt) dst[dt * 16] = f2bf(o[dt][r] * iv);
        }
    }
    __syncthreads();
}

__device__ __forceinline__ void ssd1_item(const Params& p, int l, int ci, unsigned char* smem) {
    const int tid = opaque(threadIdx.x), lane = tid & 63, w = tid >> 6, fr = lane & 15, fq = lane >> 4;
    const Item it = decode_item(ci);
    bf16_t* xwT = (bf16_t*)smem;
    bf16_t* BT = (bf16_t*)(smem + 36864);
    float* dts = (float*)(smem + 55296);
    float* acs = dts + 256;
    float* wts = acs + 256;
    bf16_t* raw = (bf16_t*)(smem + 58368);
    const bf16_t* u = (const bf16_t*)(p.ws + WS_U);
    const bf16_t* xb = (const bf16_t*)(p.ws + WS_XB);
    const float* part = (const float*)(p.ws + WS_PART);
    const float* wdt = (const float*)(p.ws + WS_WDT) + (size_t)l * 4096;
    bf16_t* xcT = (bf16_t*)(p.ws + WS_XCT) + (size_t)ci * 16384;
    const int chh = tid < 384 ? tid : 0;
    const float cw0 = p.ssm_conv_w[(l * 4 + 0) * 512 + chh], cw1 = p.ssm_conv_w[(l * 4 + 1) * 512 + chh], cw2 = p.ssm_conv_w[(l * 4 + 2) * 512 + chh], cw3 = p.ssm_conv_w[(l * 4 + 3) * 512 + chh];
    const float cbias = p.ssm_conv_b[l * 512 + chh];
    const float dtb = p.ssm_dt_bias[l * 4 + ((lane >> 1) & 3)], alog = p.ssm_a_log[l * 4 + (w & 3)];
    u32x4 rv[7];
    {
        const int nrow = it.L + 3;
#pragma unroll
        for (int i = 0; i < 7; ++i) {
            const int idx = tid + NTHR * i, rr = idx / 48, pc = idx - rr * 48;
            u32x4 v = (u32x4){0u, 0u, 0u, 0u};
            if (rr < nrow) {
                if (rr >= 3 || (!it.samp && it.t0 > 0)) v = *(const u32x4*)(u + (size_t)(it.r0 + rr - 3) * NU + 256 + pc * 8);
                else if (it.samp) v = load8f_bf(p.state_ssm_conv + ((size_t)(l * NS + it.s) * 3 + rr) * 512 + pc * 8);
            }
            rv[i] = v;
        }
    }
    {
        u32x4 x0[8], x1[8];
#pragma unroll
        for (int tt = 0; tt < 8; ++tt) {
            const int t = w * 8 + tt;
            x0[tt] = (u32x4){0u, 0u, 0u, 0u}; x1[tt] = x0[tt];
            if (t < it.L) { const bf16_t* xr = xb + (size_t)(it.r0 + t) * D + lane * 16; x0[tt] = *(const u32x4*)xr; x1[tt] = *(const u32x4*)(xr + 8); }
        }
        f32x4 wv[4][4];
#pragma unroll
        for (int h = 0; h < 4; ++h)
#pragma unroll
            for (int e4 = 0; e4 < 4; ++e4) wv[h][e4] = *(const f32x4*)(wdt + h * 1024 + lane * 16 + 4 * e4);
#pragma unroll
        for (int i = 0; i < 7; ++i) { const int idx = tid + NTHR * i, rr = idx / 48, pc = idx - rr * 48; if (rr < 67) *(u32x4*)(raw + rr * 384 + pc * 8) = rv[i]; }
        float pv[32];
#pragma unroll
        for (int tt = 0; tt < 8; ++tt) {
            float xf[16];
#pragma unroll
            for (int e = 0; e < 4; ++e) { xf[2 * e] = bflo(x0[tt][e]); xf[2 * e + 1] = bfhi(x0[tt][e]); xf[8 + 2 * e] = bflo(x1[tt][e]); xf[8 + 2 * e + 1] = bfhi(x1[tt][e]); }
#pragma unroll
            for (int h = 0; h < 4; ++h) {
                float a = 0.f;
#pragma unroll
                for (int e4 = 0; e4 < 4; ++e4) a += xf[4 * e4] * wv[h][e4][0] + xf[4 * e4 + 1] * wv[h][e4][1] + xf[4 * e4 + 2] * wv[h][e4][2] + xf[4 * e4 + 3] * wv[h][e4][3];
                pv[tt * 4 + h] = a;
            }
        }
        const float mine = wave_sum_multi<32>(pv, lane);
        if ((lane & 1) == 0) {
            const int idx = lane >> 1, t = w * 8 + (idx >> 2), h = idx & 3;
            const bool ok = t < it.L; const float rs = ok ? rstd_row(part, it.r0 + t) : 0.f;
            const float rawv = mine * rs + dtb;
            dts[t * 4 + h] = ok ? (rawv > 20.f ? rawv : __logf(1.f + __expf(rawv))) : 0.f;
        }
    }
    __syncthreads();
    if (w < 4) {
        const int h = w; const float A = -__expf(alog);
        const float dtv = dts[lane * 4 + h]; float v = dtv * A;
#pragma unroll
        for (int o = 1; o < 64; o <<= 1) { const float n = __shfl_up(v, o); if (lane >= o) v += n; }
        const float endv = __shfl(v, 63);
        acs[lane * 4 + h] = v; wts[lane * 4 + h] = __expf(endv - v) * dtv;
        if (lane < it.L) { ((float*)(p.ws + WS_DT))[(size_t)(it.r0 + lane) * 4 + h] = dtv; ((float*)(p.ws + WS_AC))[(size_t)(it.r0 + lane) * 4 + h] = v; }
        if (!it.samp && lane == 0) ((float*)(p.ws + WS_DEC))[ci * 4 + h] = __expf(endv);
    }
    __syncthreads();
    if (tid < 384) {
        const int ch = tid;
        const float w0 = cw0, w1 = cw1, w2 = cw2, w3 = cw3, bias = cbias;
        const int hh = ch >> 6;
#pragma unroll 1
        for (int g = 0; g < 8; ++g) {
            float v[8], vw[8];
            if (g * 8 < it.L) {
                float xr[11];
#pragma unroll
                for (int j = 0; j < 11; ++j) xr[j] = bf2f(raw[(g * 8 + j) * 384 + ch]);
#pragma unroll
                for (int j = 0; j < 8; ++j) v[j] = siluf_(bias + w0 * xr[j] + w1 * xr[j + 1] + w2 * xr[j + 2] + w3 * xr[j + 3]);
            } else {
#pragma unroll
                for (int j = 0; j < 8; ++j) v[j] = 0.f;
            }
            if (ch < 256) {
                *(u32x4*)(xcT + ch * 64 + g * 8) = pack8(v);
#pragma unroll
                for (int j = 0; j < 8; ++j) vw[j] = v[j] * wts[(g * 8 + j) * 4 + hh];
                *(u32x4*)(xwT + ch * 72 + g * 8) = pack8(vw);
            } else *(u32x4*)(BT + (ch - 256) * 72 + g * 8) = pack8(v);
        }
    }
    __syncthreads();
    {
        const int h = w >> 1, ph = w & 1;
        f32x4 acc[2][8];
#pragma unroll
        for (int i = 0; i < 2; ++i)
#pragma unroll
            for (int j = 0; j < 8; ++j) acc[i][j] = (f32x4){0.f, 0.f, 0.f, 0.f};
#pragma unroll
        for (int ks = 0; ks < 2; ++ks) {
            bf16x8 xf[2];
#pragma unroll
            for (int pt = 0; pt < 2; ++pt) xf[pt] = *(const bf16x8*)(xwT + (h * 64 + ph * 32 + pt * 16 + fr) * 72 + ks * 32 + fq * 8);
#pragma unroll
            for (int nt = 0; nt < 8; ++nt) {
                const bf16x8 bfr = *(const bf16x8*)(BT + (nt * 16 + fr) * 72 + ks * 32 + fq * 8);
#pragma unroll
                for (int pt = 0; pt < 2; ++pt) acc[pt][nt] = mfma16(bfr, xf[pt], acc[pt][nt]);
            }
        }
        const float dec = __expf(acs[63 * 4 + h]);
#pragma unroll
        for (int pt = 0; pt < 2; ++pt)
#pragma unroll
            for (int nt = 0; nt < 8; ++nt) {
                const int pp = ph * 32 + pt * 16 + fr, n = nt * 16 + fq * 4;
                if (!it.samp) *(f32x4*)((float*)(p.ws + WS_S) + (((size_t)ci * 4 + h) * 64 + pp) * 128 + n) = acc[pt][nt];
                else { const size_t o = (((size_t)(l * NS + it.s) * 4 + h) * 64 + pp) * 128 + n; const f32x4 h0 = *(const f32x4*)(p.state_ssm + o); *(f32x4*)(p.out + O_SSM_S + o) = h0 * dec + acc[pt][nt]; }
            }
    }
    __syncthreads();
}

__device__ __forceinline__ void ssd3_item(const Params& p, int l, int ci, unsigned char* smem) {
    const int tid = opaque(threadIdx.x), lane = tid & 63, w = tid >> 6, fr = lane & 15, fq = lane >> 4;
    const Item it = decode_item(ci);
    bf16_t* xT = (bf16_t*)smem;
    bf16_t* Bm = (bf16_t*)(smem + 36864);
    bf16_t* Cm = (bf16_t*)(smem + 54272);
    bf16_t* G = (bf16_t*)(smem + 71680);
    float* yg = (float*)(smem + 36864);
    float* dts = (float*)(smem + 108544);
    float* acs = dts + 256;
    const bf16_t* u = (const bf16_t*)(p.ws + WS_U);
    bf16_t* mix = (bf16_t*)(p.ws + WS_MIX);
    bf16x8 hfr[4][4];
    {
        const int hh_ = w >> 1;
        if (it.samp) {
            const float* hs = p.state_ssm + ((size_t)(l * NS + it.s) * 4 + hh_) * 8192;
#pragma unroll
            for (int ks = 0; ks < 4; ++ks)
#pragma unroll
                for (int pt = 0; pt < 4; ++pt) hfr[ks][pt] = __builtin_bit_cast(bf16x8, load8f_bf(hs + (size_t)(pt * 16 + fr) * 128 + ks * 32 + fq * 8));
        } else {
            const bf16_t* hs = (const bf16_t*)(p.ws + WS_XC) + ((size_t)ci * 4 + hh_) * 8192;
#pragma unroll
            for (int ks = 0; ks < 4; ++ks)
#pragma unroll
                for (int pt = 0; pt < 4; ++pt) hfr[ks][pt] = *(const bf16x8*)(hs + (size_t)(pt * 16 + fr) * 128 + ks * 32 + fq * 8);
        }
    }
    bf16_t* raw2 = G;
    const int cc_ = 256 + (tid & 255);
    const float cw0 = p.ssm_conv_w[(l * 4 + 0) * 512 + cc_], cw1 = p.ssm_conv_w[(l * 4 + 1) * 512 + cc_], cw2 = p.ssm_conv_w[(l * 4 + 2) * 512 + cc_], cw3 = p.ssm_conv_w[(l * 4 + 3) * 512 + cc_];
    const float cbias = p.ssm_conv_b[l * 512 + cc_];
    const float dsk = p.ssm_d[l * 4 + (w >> 1)];
    const f32x4 gn = *(const f32x4*)(p.ssm_norm + l * 256 + lane * 4);
    {
        const bf16_t* xcT = (const bf16_t*)(p.ws + WS_XCT) + (size_t)ci * 16384;
        const int nrow = it.L + 3;
        u32x4 xv[4], rv[5];
#pragma unroll
        for (int i = 0; i < 4; ++i) xv[i] = *(const u32x4*)(xcT + (tid + NTHR * i) * 8);
#pragma unroll
        for (int i = 0; i < 5; ++i) {
            const int idx = tid + NTHR * i, rr = idx >> 5, pc = idx & 31;
            u32x4 v = (u32x4){0u, 0u, 0u, 0u};
            if (rr < nrow) {
                if (rr >= 3 || (!it.samp && it.t0 > 0)) v = *(const u32x4*)(u + (size_t)(it.r0 + rr - 3) * NU + 512 + pc * 8);
                else if (it.samp) v = load8f_bf(p.state_ssm_conv + ((size_t)(l * NS + it.s) * 3 + rr) * 512 + 256 + pc * 8);
            }
            rv[i] = v;
        }
#pragma unroll
        for (int i = 0; i < 4; ++i) { const int idx = tid + NTHR * i; *(u32x4*)(xT + (idx >> 3) * 72 + (idx & 7) * 8) = xv[i]; }
#pragma unroll
        for (int i = 0; i < 5; ++i) { const int idx = tid + NTHR * i, rr = idx >> 5, pc = idx & 31; if (rr < 67) *(u32x4*)(raw2 + rr * 256 + pc * 8) = rv[i]; }
    }
    if (tid < 256) {
        const int t = tid >> 2;
        dts[tid] = t < it.L ? ((const float*)(p.ws + WS_DT))[(size_t)it.r0 * 4 + tid] : 0.f;
        acs[tid] = t < it.L ? ((const float*)(p.ws + WS_AC))[(size_t)it.r0 * 4 + tid] : 0.f;
    }
    __syncthreads();
    {
        const int ch = tid & 255, th = tid >> 8;
        const float w0 = cw0, w1 = cw1, w2 = cw2, w3 = cw3, bias = cbias;
        bf16_t* dstm = ch < 128 ? Bm + ch : Cm + (ch - 128);
#pragma unroll 1
        for (int g = 0; g < 4; ++g) {
            const int tb = th * 32 + g * 8;
            if (tb < it.L) {
                float xr[11];
#pragma unroll
                for (int j = 0; j < 11; ++j) xr[j] = bf2f(raw2[(tb + j) * 256 + ch]);
#pragma unroll
                for (int j = 0; j < 8; ++j) dstm[(tb + j) * 136] = f2bf(siluf_(bias + w0 * xr[j] + w1 * xr[j + 1] + w2 * xr[j + 2] + w3 * xr[j + 3]));
            } else {
#pragma unroll
                for (int j = 0; j < 8; ++j) dstm[(tb + j) * 136] = 0;
            }
        }
    }
    __syncthreads();
    {
        const int itl = w & 3, jh = w >> 2;
        f32x4 cb[2]; cb[0] = (f32x4){0.f, 0.f, 0.f, 0.f}; cb[1] = cb[0];
#pragma unroll
        for (int ks = 0; ks < 4; ++ks) {
            const bf16x8 cf = *(const bf16x8*)(Cm + (itl * 16 + fr) * 136 + ks * 32 + fq * 8);
#pragma unroll
            for (int jj = 0; jj < 2; ++jj) { const bf16x8 bfr = *(const bf16x8*)(Bm + ((jh * 2 + jj) * 16 + fr) * 136 + ks * 32 + fq * 8); cb[jj] = mfma16(bfr, cf, cb[jj]); }
        }
        const int i = itl * 16 + fr;
#pragma unroll
        for (int h = 0; h < 4; ++h) {
            const float ai = acs[i * 4 + h];
#pragma unroll
            for (int jj = 0; jj < 2; ++jj) {
                const int j0 = (jh * 2 + jj) * 16 + fq * 4;
                float gv[4];
#pragma unroll
                for (int r = 0; r < 4; ++r) { const int j = j0 + r; gv[r] = (j <= i) ? cb[jj][r] * __expf(ai - acs[j * 4 + h]) * dts[j * 4 + h] : 0.f; }
                u32x2 pk; pk[0] = pack_bf16(gv[0], gv[1]); pk[1] = pack_bf16(gv[2], gv[3]);
                *(u32x2*)(G + (h * 64 + i) * 72 + j0) = pk;
            }
        }
    }
    __syncthreads();
    const int h = w >> 1, ih = w & 1;
    f32x4 yi[2][4], ye[2][4];
#pragma unroll
    for (int a = 0; a < 2; ++a)
#pragma unroll
        for (int b = 0; b < 4; ++b) { yi[a][b] = (f32x4){0.f, 0.f, 0.f, 0.f}; ye[a][b] = yi[a][b]; }
#pragma unroll
    for (int ks = 0; ks < 2; ++ks) {
        bf16x8 gf[2];
#pragma unroll
        for (int a = 0; a < 2; ++a) gf[a] = *(const bf16x8*)(G + (h * 64 + (ih * 2 + a) * 16 + fr) * 72 + ks * 32 + fq * 8);
#pragma unroll
        for (int pt = 0; pt < 4; ++pt) {
            const bf16x8 xf = *(const bf16x8*)(xT + (h * 64 + pt * 16 + fr) * 72 + ks * 32 + fq * 8);
#pragma unroll
            for (int a = 0; a < 2; ++a) yi[a][pt] = mfma16(gf[a], xf, yi[a][pt]);
        }
    }
#pragma unroll
    for (int ks = 0; ks < 4; ++ks) {
        bf16x8 cf[2];
#pragma unroll
        for (int a = 0; a < 2; ++a) cf[a] = *(const bf16x8*)(Cm + ((ih * 2 + a) * 16 + fr) * 136 + ks * 32 + fq * 8);
#pragma unroll
        for (int pt = 0; pt < 4; ++pt)
#pragma unroll
            for (int a = 0; a < 2; ++a) ye[a][pt] = mfma16(cf[a], hfr[ks][pt], ye[a][pt]);
    }
#pragma unroll
    for (int a = 0; a < 2; ++a)
#pragma unroll
        for (int r = 0; r < 4; ++r) {
            const int i = (ih * 2 + a) * 16 + fq * 4 + r; const float ea = __expf(acs[i * 4 + h]);
#pragma unroll
            for (int pt = 0; pt < 4; ++pt) {
                const int pp = pt * 16 + fr;
                const float xv = bf2f(xT[(h * 64 + pp) * 72 + i]);
                yi[a][pt][r] = yi[a][pt][r] + ea * ye[a][pt][r] + dsk * xv;
            }
        }
    u32x2 zz[8];
#pragma unroll
    for (int tt = 0; tt < 8; ++tt) { const int t = w * 8 + tt; zz[tt] = (u32x2){0u, 0u}; if (t < it.L) zz[tt] = *(const u32x2*)(u + (size_t)(it.r0 + t) * NU + lane * 4); }
    __syncthreads();
#pragma unroll
    for (int a = 0; a < 2; ++a)
#pragma unroll
        for (int r = 0; r < 4; ++r) {
            const int i = (ih * 2 + a) * 16 + fq * 4 + r;
#pragma unroll
            for (int pt = 0; pt < 4; ++pt) yg[i * 256 + h * 64 + pt * 16 + fr] = yi[a][pt][r];
        }
    __syncthreads();
    {
        f32x4 vv[8]; float sq[8];
#pragma unroll
        for (int tt = 0; tt < 8; ++tt) {
            f32x4 v = *(const f32x4*)(yg + (w * 8 + tt) * 256 + lane * 4);
            v[0] *= siluf_(bflo(zz[tt][0])); v[1] *= siluf_(bfhi(zz[tt][0])); v[2] *= siluf_(bflo(zz[tt][1])); v[3] *= siluf_(bfhi(zz[tt][1]));
            vv[tt] = v; sq[tt] = v[0] * v[0] + v[1] * v[1] + v[2] * v[2] + v[3] * v[3];
        }
        const float tot = wave_sum_multi<8>(sq, lane);
#pragma unroll
        for (int tt = 0; tt < 8; ++tt) {
            const int t = w * 8 + tt;
            const float rs = rsqrtf(__shfl(tot, tt * 8) * (1.f / 256.f) + EPS);
            if (t < it.L) {
                const f32x4 v = vv[tt];
                u32x2 pk; pk[0] = pack_bf16(v[0] * rs * gn[0], v[1] * rs * gn[1]); pk[1] = pack_bf16(v[2] * rs * gn[2], v[3] * rs * gn[3]);
                *(u32x2*)(mix + (size_t)(it.r0 + t) * D + lane * 4) = pk;
            }
        }
    }
    __syncthreads();
}

__device__ __forceinline__ void sconv_item(const Params& p, int l, int ci) {
    const int tid = opaque(threadIdx.x), cgp = tid & 31, tq = tid >> 5, c0 = cgp * 8;
    const Item it = decode_item(ci);
    const bf16_t* u = (const bf16_t*)(p.ws + WS_U);
    bf16_t* mix = (bf16_t*)(p.ws + WS_MIX);
    const int nt = it.L >> 4, ts = tq * nt;
    float w0[8], w1[8], w2[8];
#pragma unroll
    for (int k4 = 0; k4 < 2; ++k4) {
        const f32x4 a = *(const f32x4*)(p.sconv_w + (l * 3 + 0) * 256 + c0 + 4 * k4), b = *(const f32x4*)(p.sconv_w + (l * 3 + 1) * 256 + c0 + 4 * k4), c = *(const f32x4*)(p.sconv_w + (l * 3 + 2) * 256 + c0 + 4 * k4);
#pragma unroll
        for (int e = 0; e < 4; ++e) { w0[4 * k4 + e] = a[e]; w1[4 * k4 + e] = b[e]; w2[4 * k4 + e] = c[e]; }
    }
    u32x4 cgv[6], bgv[4];
    f32x4 st0[2], st1[2];
    const bool need_state = it.samp && ts < 2;
#pragma unroll
    for (int j = 0; j < 6; ++j) {
        cgv[j] = (u32x4){0u, 0u, 0u, 0u};
        const int tl = ts - 2 + j;
        if (j < nt + 2 && (tl >= 0 || (!it.samp && it.t0 + tl >= 0))) { const bf16_t* ur = u + (size_t)(it.r0 + tl) * NU + c0; cgv[j] = *(const u32x4*)(ur + 1536); }
    }
#pragma unroll
    for (int j = 0; j < 2; ++j) {
        st0[j] = (f32x4){0.f, 0.f, 0.f, 0.f}; st1[j] = st0[j];
        if (need_state && ts - 2 + j < 0) { const float* sp = p.state_sconv + ((size_t)(l * NS + it.s) * 2 + (ts + j)) * 256 + c0; st0[j] = *(const f32x4*)sp; st1[j] = *(const f32x4*)(sp + 4); }
    }
#pragma unroll
    for (int j = 0; j < 4; ++j) { bgv[j] = (u32x4){0u, 0u, 0u, 0u}; if (j < nt) bgv[j] = *(const u32x4*)(u + (size_t)(it.r0 + ts + j) * NU + 1280 + c0); }
    float pv[6][8];
#pragma unroll
    for (int j = 0; j < 6; ++j)
#pragma unroll
        for (int q = 0; q < 4; ++q) { pv[j][2 * q] = bflo(cgv[j][q]); pv[j][2 * q + 1] = bfhi(cgv[j][q]); }
#pragma unroll
    for (int j = 0; j < 2; ++j)
        if (need_state && ts - 2 + j < 0) {
#pragma unroll
            for (int e = 0; e < 4; ++e) { pv[j][e] = st0[j][e]; pv[j][4 + e] = st1[j][e]; }
        }
    const bool wr_state = it.samp || it.c == 63;
    float* sdst = it.samp ? p.out + O_SC_S + (size_t)(l * NS + it.s) * 512 + c0 : p.out + O_SC_P + (size_t)(l * NB + it.b) * 512 + c0;
#pragma unroll
    for (int j = 0; j < 4; ++j) {
        if (j < nt) {
            const int t = ts + j;
            float o[8];
#pragma unroll
            for (int q = 0; q < 4; ++q) {
                o[2 * q] = bflo(bgv[j][q]) * (w0[2 * q] * pv[j][2 * q] + w1[2 * q] * pv[j + 1][2 * q] + w2[2 * q] * pv[j + 2][2 * q]);
                o[2 * q + 1] = bfhi(bgv[j][q]) * (w0[2 * q + 1] * pv[j][2 * q + 1] + w1[2 * q + 1] * pv[j + 1][2 * q + 1] + w2[2 * q + 1] * pv[j + 2][2 * q + 1]);
            }
            *(u32x4*)(mix + (size_t)(it.r0 + t) * D + 512 + c0) = pack8(o);
            if (wr_state && t >= it.L - 2) {
                float* d = sdst + (t - (it.L - 2)) * 256;
                *(f32x4*)d = (f32x4){pv[j + 2][0], pv[j + 2][1], pv[j + 2][2], pv[j + 2][3]}; *(f32x4*)(d + 4) = (f32x4){pv[j + 2][4], pv[j + 2][5], pv[j + 2][6], pv[j + 2][7]};
            }
        }
    }
}

__device__ __forceinline__ void cconv_item(const Params& p, int l, int ci, unsigned char* smem) {
    const int tid = opaque(threadIdx.x), lane = tid & 63, w = tid >> 6;
    const Item it = decode_item(ci);
    bf16_t* gl = (bf16_t*)smem;
    float* yb = (float*)(smem + 49152);
    const bf16_t* u = (const bf16_t*)(p.ws + WS_U);
    bf16_t* mix = (bf16_t*)(p.ws + WS_MIX);
    const int nrows = 30 + it.L;
    float wk[31];
#pragma unroll
    for (int k = 0; k < 31; ++k) wk[k] = p.cconv_w[(l * 31 + k) * 256 + (tid & 255)];
    const float bias = p.cconv_b[l * 256 + (tid & 255)];
    const f32x4 gn = *(const f32x4*)(p.cconv_ln_g + l * 256 + lane * 4), bn = *(const f32x4*)(p.cconv_ln_b + l * 256 + lane * 4);
    {
        u32x4 av[6];
#pragma unroll
        for (int i = 0; i < 6; ++i) {
            const int idx = tid + NTHR * i, li = idx >> 5, part = idx & 31, tg = it.t0 - 30 + li;
            av[i] = (u32x4){0u, 0u, 0u, 0u};
            if (li < nrows) {
                if (tg >= 0) { const bf16_t* ur = u + (size_t)(it.r0 - it.t0 + tg) * NU + part * 8; av[i] = *(const u32x4*)(ur + 1792); }
                else if (it.samp) { const float* sb = p.state_cconv + ((size_t)(l * NS + it.s) * 30 + li) * 256 + part * 8; av[i] = load8f_bf(sb); }
            }
        }
#pragma unroll
        for (int i = 0; i < 6; ++i) {
            const int idx = tid + NTHR * i, li = idx >> 5, part = idx & 31;
            if (li < nrows) *(u32x4*)(gl + li * 256 + part * 8) = av[i];
        }
    }
    __syncthreads();
    if (it.samp || it.c == 63) {
        float* dst = it.samp ? p.out + O_CC_S + (size_t)(l * NS + it.s) * 7680 : p.out + O_CC_P + (size_t)(l * NB + it.b) * 7680;
        for (int idx = tid; idx < 7680; idx += NTHR) dst[idx] = bf2f(gl[it.L * 256 + idx]);
    }
    {
        const int ch = tid & 255, th = tid >> 8, nt = it.L / 2;
#pragma unroll 1
        for (int tb = th * nt; tb < th * nt + nt; tb += 8) {
            float xr[38];
#pragma unroll
            for (int j = 0; j < 38; ++j) xr[j] = bf2f(gl[(tb + j) * 256 + ch]);
#pragma unroll
            for (int j = 0; j < 8; ++j) {
                float a = bias;
#pragma unroll
                for (int k = 0; k < 31; ++k) a += wk[k] * xr[j + k];
                yb[(tb + j) * 256 + ch] = a;
            }
        }
    }
    __syncthreads();
    {
        f32x4 vv[8]; float sm[8];
#pragma unroll
        for (int tt = 0; tt < 8; ++tt) { vv[tt] = *(const f32x4*)(yb + (w * 8 + tt) * 256 + lane * 4); sm[tt] = (vv[tt][0] + vv[tt][1]) + (vv[tt][2] + vv[tt][3]); }
        const float tsum = wave_sum_multi<8>(sm, lane);
#pragma unroll
        for (int tt = 0; tt < 8; ++tt) {
            const float mean = __shfl(tsum, tt * 8) * (1.f / 256.f);
            vv[tt] = vv[tt] - mean;
            sm[tt] = (vv[tt][0] * vv[tt][0] + vv[tt][1] * vv[tt][1]) + (vv[tt][2] * vv[tt][2] + vv[tt][3] * vv[tt][3]);
        }
        const float tsq = wave_sum_multi<8>(sm, lane);
#pragma unroll
        for (int tt = 0; tt < 8; ++tt) {
            const int t = w * 8 + tt;
            const float rs = rsqrtf(__shfl(tsq, tt * 8) * (1.f / 256.f) + EPS);
            if (t < it.L) {
                float o[4];
#pragma unroll
                for (int e = 0; e < 4; ++e) o[e] = siluf_(vv[tt][e] * rs * gn[e] + bn[e]);
                u32x2 pk; pk[0] = pack_bf16(o[0], o[1]); pk[1] = pack_bf16(o[2], o[3]);
                *(u32x2*)(mix + (size_t)(it.r0 + t) * D + 768 + lane * 4) = pk;
            }
        }
    }
    __syncthreads();
}

__device__ __forceinline__ void state_copies(const Params& p, int l) {
    const bf16_t* u = (const bf16_t*)(p.ws + WS_U);
    const int gt = blockIdx.x * NTHR + opaque(threadIdx.x), gs = gridDim.x * NTHR;
    for (int e = gt; e < 65536; e += gs) {
        const int b = e >> 14, i = (e >> 7) & 127, cd = e & 127;
        const bf16_t* src = u + (size_t)(b * SEQ + SEQ - 128 + i) * NU + cd;
        p.out[O_K_P + (size_t)l * 65536 + e] = bf2f(src[1024]); p.out[O_V_P + (size_t)l * 65536 + e] = bf2f(src[1152]);
        const int s = e >> 11, t = (e >> 7) & 15;
        const bf16_t* src2 = u + (size_t)(MP + s * LS + t) * NU + cd;
        p.out[O_K_S + (size_t)l * 65536 + e] = bf2f(src2[1024]); p.out[O_V_S + (size_t)l * 65536 + e] = bf2f(src2[1152]);
    }
    for (int e = gt; e < 6144; e += gs) {
        const int b = e / 1536, i = (e / 512) % 3, ch = e & 511;
        p.out[O_SCV_P + (size_t)l * 6144 + e] = bf2f(u[(size_t)(b * SEQ + SEQ - 3 + i) * NU + 256 + ch]);
    }
    for (int e = gt; e < 49152; e += gs) {
        const int s = e / 1536, i = (e / 512) % 3, ch = e & 511;
        p.out[O_SCV_S + (size_t)l * 49152 + e] = bf2f(u[(size_t)(MP + s * LS + LS - 3 + i) * NU + 256 + ch]);
    }
}

__global__ void __launch_bounds__(NTHR, 2) mega(Params p0, int ph_lo, int ph_hi) {
    extern __shared__ __attribute__((aligned(16))) unsigned char smem[];
    if (threadIdx.x < 4) ((volatile unsigned*)(smem + LDS_BYTES))[threadIdx.x] = 0u;
    __syncthreads();
    XcdBarrier xb = xcd_barrier_post((unsigned*)(p0.ws + WS_BAR), (volatile LAS unsigned*)(smem + LDS_BYTES));
    for (int ph = ph_lo; ph < ph_hi; ++ph) {
        if (ph > ph_lo) { xcd_barrier(xb); }
        Params p = p0;
        { size_t z0 = 0, z1 = 0; asm volatile("" : "+s"(z0), "+s"(z1)); p.ws = p0.ws + z0; p.out = p0.out + z1; }
        const int tid = opaque(threadIdx.x);
        const int spid = ph == 0 ? 100 : (ph == NPH - 1 ? 101 : (ph - 1) % 7);
#if RPT_SP >= 0
        const int nrep = (spid == RPT_SP) ? RPT_N + 1 : 1;
        for (int rep = 0; rep < nrep; ++rep)
#else
        (void)spid;
#endif
        if (ph == 0) {
            int it = blockIdx.x;
            for (; it < 161; it += gridDim.x) {
                const PrepT t = prep_decode(it < 160 ? it : 752);
                const V8 v = prep_load(p, t, tid);
                prep_finish(p, t, tid, v, smem);
            }
            __syncthreads();
            {
                int r = it - 161; const int nr = MT / 8;
                Row4 cur = init_rows_load(p, r < nr ? r : 0, tid);
                for (; r < nr; r += gridDim.x) {
                    const int rn = r + gridDim.x;
                    const Row4 nxt = init_rows_load(p, rn < nr ? rn : r, tid);
                    init_rows_finish(p, r, tid, cur);
                    cur = nxt;
                }
            }
        } else if (ph == NPH - 1) {
            const float* part = (const float*)(p.ws + WS_PART);
            const int lane = tid & 63, w = tid >> 6;
            for (int it = blockIdx.x; it < MT / 8; it += gridDim.x) {
                const int row = it * 8 + w; const float rs = rstd_row(part, row);
                float* Y = p.out + (size_t)row * D; const bf16_t* xr = (const bf16_t*)(p.ws + WS_XB) + (size_t)row * D;
#pragma unroll
                for (int i = 0; i < 4; ++i) {
                    const int c = i * 256 + lane * 4;
                    const u32x2 xv = *(const u32x2*)(xr + c); const f32x4 g = *(const f32x4*)(p.norm_final + c);
                    f32x4 v; v[0] = bflo(xv[0]) * rs * g[0]; v[1] = bfhi(xv[0]) * rs * g[1]; v[2] = bflo(xv[1]) * rs * g[2]; v[3] = bfhi(xv[1]) * rs * g[3];
                    *(f32x4*)(Y + c) = v;
                }
            }
        } else {
            const int l = (ph - 1) / 7, sp = (ph - 1) % 7;
            const bf16_t* xb = (const bf16_t*)(p.ws + WS_XB);
            float* part = (float*)(p.ws + WS_PART);
            if (sp == 0) {
                EpiU e{(bf16_t*)(p.ws + WS_U), build_rstd_table(part, MT, NW, smem)};
                if (EN(7)) run_gemm(xb, (const bf16_t*)(p.ws + WS_WIN + l * W_IN_B), MT, NW, D, e, smem);
                prep_in_idle_slots(p, (MT / 256) * (NW / 256), l * 753 + 160, l * 753 + 576, 0, 0, -1, smem);
            } else if (sp == 1) {
                unsigned* ctr = (unsigned*)(p.ws + WS_BAR) + 32 * (l + 1);
                volatile int* slot = (volatile int*)(smem + LDS_BYTES + 8);
                int pre = 0;
                if (tid == 0) pre = (int)__hip_atomic_fetch_add(ctr, 1u, __ATOMIC_RELAXED, __HIP_MEMORY_SCOPE_AGENT);
                for (;;) {
                    __syncthreads();
                    if (tid == 0) *slot = pre;
                    __syncthreads();
                    const int it = *slot;
                    if (it >= 1440) break;
                    if (tid == 0) pre = (int)__hip_atomic_fetch_add(ctr, 1u, __ATOMIC_RELAXED, __HIP_MEMORY_SCOPE_AGENT);
                    if (it < 32) { ssd1_item(p, l, 256 + it, smem); ssd3_item(p, l, 256 + it, smem); }
                    else if (it < 288) ssd1_item(p, l, it - 32, smem);
                    else if (it < 864) swa_item(p, l, (it - 288) >> 1, (it - 288) & 1, smem);
                    else if (it < 1152) cconv_item(p, l, it - 864, smem);
                    else sconv_item(p, l, it - 1152);
                }
            } else if (sp == 2) {
                state_copies(p, l);
                const float* S = (const float*)(p.ws + WS_S); const float* dec = (const float*)(p.ws + WS_DEC);
                bf16_t* Hb = (bf16_t*)(p.ws + WS_XC);
                for (int e = blockIdx.x * NTHR + tid; e < 131072; e += gridDim.x * NTHR) {
                    const int b = e >> 15, rem = e & 32767, h = rem >> 13;
                    float hc = 0.f;
                    float sv[64];
#pragma unroll
                    for (int j = 0; j < 64; ++j) sv[j] = S[(size_t)(b * 64 + j) * 32768 + rem];
#pragma unroll
                    for (int c0 = 0; c0 < 64; c0 += 16) {
                        float dv[16];
#pragma unroll
                        for (int j = 0; j < 16; ++j) dv[j] = dec[(b * 64 + c0 + j) * 4 + h];
#pragma unroll
                        for (int j = 0; j < 16; ++j) { Hb[(size_t)(b * 64 + c0 + j) * 32768 + rem] = f2bf(hc); hc = dv[j] * hc + sv[c0 + j]; }
                    }
                    p.out[O_SSM_P + (size_t)(l * NB + b) * 32768 + rem] = hc;
                }
            } else if (sp == 3) {
                for (int it = blockIdx.x; it < 256; it += gridDim.x) if (EN(6)) ssd3_item(p, l, it, smem);
            } else if (sp == 4) {
                EpiRes e{(bf16_t*)(p.ws + WS_XB), part};
                if (EN(8)) { run_gemm((const bf16_t*)(p.ws + WS_MIX), (const bf16_t*)(p.ws + WS_WOUT + l * W_OUT_B), MP, D, D, e, smem);
                    gemm_small_res((const bf16_t*)(p.ws + WS_MIX), (const bf16_t*)(p.ws + WS_WOUT + l * W_OUT_B), D, (bf16_t*)(p.ws + WS_XB), part, smem); }
            } else if (sp == 5) {
                EpiGlu e{(bf16_t*)(p.ws + WS_U), build_rstd_table(part, MT, NGU, smem)};
                if (EN(9)) run_gemm(xb, (const bf16_t*)(p.ws + WS_WGU + l * W_GU_B), MT, NGU, D, e, smem);
                if (l == 0) prep_in_idle_slots(p, (MT / 256) * (NGU / 256), 576, 752, 753, 753 + 160, 753 + 752, smem);
                else prep_in_idle_slots(p, (MT / 256) * (NGU / 256), 753 + 576, 753 + 752, 0, 0, -1, smem);
            } else {
                EpiRes e{(bf16_t*)(p.ws + WS_XB), part};
                if (EN(10)) { run_gemm((const bf16_t*)(p.ws + WS_U), (const bf16_t*)(p.ws + WS_WDN + l * W_DN_B), MP, D, DFF, e, smem);
                    gemm_small_res((const bf16_t*)(p.ws + WS_U), (const bf16_t*)(p.ws + WS_WDN + l * W_DN_B), DFF, (bf16_t*)(p.ws + WS_XB), part, smem); }
            }
        }
    }
}

extern "C" void kernel_launch(void* const* d_in, const int* in_sizes, int n_in, void* d_out, int out_size, void* d_ws, size_t ws_size, hipStream_t stream) {
    static int grid = 0;
    if (grid == 0) {
        if (n_in != 28 || ws_size < WS_END || (size_t)out_size != O_END) { fprintf(stderr, "kernel_launch: unexpected shapes (n_in %d, out %d, ws %zu)\n", n_in, out_size, ws_size); grid = -1; return; }
        int dev = 0, cus = 0, per_cu = 0;
        hipGetDevice(&dev); hipDeviceGetAttribute(&cus, hipDeviceAttributeMultiprocessorCount, dev);
        if (hipFuncSetAttribute((const void*)mega, hipFuncAttributeMaxDynamicSharedMemorySize, LDS_TOTAL) != hipSuccess) { fprintf(stderr, "hipFuncSetAttribute failed\n"); grid = -1; return; }
        if (hipOccupancyMaxActiveBlocksPerMultiprocessor(&per_cu, (const void*)mega, NTHR, LDS_TOTAL) != hipSuccess || per_cu < 1) { fprintf(stderr, "occupancy query failed (%d)\n", per_cu); grid = -1; return; }
        grid = cus * 1;
    }
    if (grid < 0) return;
    if (hipMemsetAsync((unsigned char*)d_ws + WS_BAR, 0, 16384, stream) != hipSuccess) { fprintf(stderr, "memset failed\n"); return; }
    Params p{};
    const float** pp = (const float**)&p;
    for (int i = 0; i < 28; ++i) pp[i] = (const float*)d_in[i];
    p.out = (float*)d_out; p.ws = (unsigned char*)d_ws;
#if MK_MULTI
    for (int ph = 0; ph < NPH; ++ph) hipLaunchKernelGGL(mega, dim3(grid), dim3(NTHR), LDS_TOTAL, stream, p, ph, ph + 1);
#else
    int lo = 0, hi = NPH;
    void* args[] = {&p, &lo, &hi};
    hipError_t e = hipLaunchCooperativeKernel((const void*)mega, dim3(grid), dim3(NTHR), args, LDS_TOTAL, stream);
    if (e != hipSuccess) fprintf(stderr, "cooperative launch failed: %s (grid %d)\n", hipGetErrorString(e), grid);
#endif
}
```
